# Optimizing an MI355X kernel written in HIP

```python
import math
import jax, jax.numpy as jnp
from jax import lax
import numpy as np

D_MODEL = 2048
BATCH = 2
SEQ = 8192
DEPTH = 1

HEAD_DIM = 128
SB_HEADS = 8
MOBA_HEADS = 8
SB_WIDTH = SB_HEADS * HEAD_DIM
MOBA_WIDTH = MOBA_HEADS * HEAD_DIM
Q_BLOCK = 128
MOBA_BLOCK = 256
MOBA_TOPK = 3
MOBA_Q_CHUNK = 32
REL_BUCKETS = 32
REL_MAX_DIST = 1024
PEER_HEADS = 8
PEER_NKEYS = 128
PEER_N_EXPERTS = PEER_NKEYS * PEER_NKEYS
PEER_QDIM = 256
PEER_TOPK = 16
PEER_TOK_CHUNK = 128
LN_EPS = 1e-5
DN_ALPHA = (2.0 * DEPTH) ** 0.25
DN_BETA = (8.0 * DEPTH) ** -0.25
NEG = -1e30

kernel_name = "hybrid_sb_moba_peer_deepnorm"


def layer_norm(x, g, b):
    xf = x.astype(jnp.float32)
    mu = jnp.mean(xf, axis=-1, keepdims=True)
    var = jnp.mean(jnp.square(xf - mu), axis=-1, keepdims=True)
    y = (xf - mu) * lax.rsqrt(var + LN_EPS)
    return (y * g.astype(jnp.float32) + b.astype(jnp.float32)).astype(x.dtype)


def rel_bucket(rel):
    n_exact = REL_BUCKETS // 2
    rel = jnp.maximum(rel, 0)
    logd = jnp.log(jnp.maximum(rel, 1).astype(jnp.float32) / n_exact) / math.log(REL_MAX_DIST / n_exact)
    large = n_exact + (logd * (REL_BUCKETS - n_exact)).astype(jnp.int32)
    large = jnp.minimum(large, REL_BUCKETS - 1)
    return jnp.where(rel < n_exact, rel, large)


def stick_breaking_attention(q, k, v):
    B, H, S, dh = q.shape
    nblk = S // Q_BLOCK
    scale = dh ** -0.5
    qb = q.reshape(B, H, nblk, Q_BLOCK, dh).transpose(2, 0, 1, 3, 4)
    key_pos = jnp.arange(S)

    def block(args):
        qi, i = args
        z = jnp.einsum('bhqd,bhkd->bhqk', qi, k, preferred_element_type=jnp.float32) * scale
        q_pos = i * Q_BLOCK + jnp.arange(Q_BLOCK)
        causal = key_pos[None, :] < q_pos[:, None]
        log_1mb = jnp.where(causal, jax.nn.log_sigmoid(-z), 0.0)
        tail = lax.cumsum(log_1mb, axis=3, reverse=True) - log_1mb
        w = jnp.where(causal, jnp.exp(jax.nn.log_sigmoid(z) + tail), 0.0)
        return jnp.einsum('bhqk,bhkd->bhqd', w.astype(v.dtype), v)

    out = lax.map(block, (qb, jnp.arange(nblk)))
    return out.transpose(1, 2, 0, 3, 4).reshape(B, H, S, dh)


def moba_attention(q, k, v, rel_bias):
    B, H, S, dh = q.shape
    nb = S // MOBA_BLOCK
    ksel = min(MOBA_TOPK, nb)
    nchunk = S // MOBA_Q_CHUNK
    scale = dh ** -0.5
    kb = k.reshape(B, H, nb, MOBA_BLOCK, dh)
    vb = v.reshape(B, H, nb, MOBA_BLOCK, dh)
    k_mean = jnp.mean(kb.astype(jnp.float32), axis=3)
    qc = q.reshape(B, H, nchunk, MOBA_Q_CHUNK, dh).transpose(2, 0, 1, 3, 4)
    b_idx = jnp.arange(B)[:, None, None, None]
    h_idx = jnp.arange(H)[None, :, None, None]
    h5 = jnp.arange(H)[None, :, None, None, None]
    offs = jnp.arange(MOBA_BLOCK)
    blk_ids = jnp.arange(nb)

    def chunk(args):
        qi, c = args
        q_pos = c * MOBA_Q_CHUNK + jnp.arange(MOBA_Q_CHUNK)
        own = (c * MOBA_Q_CHUNK) // MOBA_BLOCK
        gate = jnp.einsum('bhqd,bhnd->bhqn', qi.astype(jnp.float32), k_mean)
        gate = jnp.where(blk_ids < own, gate, NEG)
        _, sel = lax.top_k(gate, ksel)
        sel_valid = jnp.arange(ksel) < own
        sel = jnp.where(sel_valid, sel, 0)
        k_sel = kb[b_idx, h_idx, sel]
        v_sel = vb[b_idx, h_idx, sel]
        s_sel = jnp.einsum('bhqd,bhqrkd->bhqrk', qi, k_sel, preferred_element_type=jnp.float32) * scale
        pos_sel = sel[..., None] * MOBA_BLOCK + offs
        bucket_sel = rel_bucket(q_pos[None, None, :, None, None] - pos_sel)
        s_sel = s_sel + rel_bias[h5, bucket_sel].astype(jnp.float32)
        s_sel = jnp.where(sel_valid[:, None], s_sel, NEG)
        k_own = lax.dynamic_index_in_dim(kb, own, axis=2, keepdims=False)
        v_own = lax.dynamic_index_in_dim(vb, own, axis=2, keepdims=False)
        own_pos = own * MOBA_BLOCK + offs
        s_own = jnp.einsum('bhqd,bhkd->bhqk', qi, k_own, preferred_element_type=jnp.float32) * scale
        s_own = s_own + rel_bias[:, rel_bucket(q_pos[:, None] - own_pos[None, :])][None].astype(jnp.float32)
        s_own = jnp.where(own_pos[None, :] <= q_pos[:, None], s_own, NEG)
        Qc = MOBA_Q_CHUNK
        logits = jnp.concatenate([s_sel.reshape(B, H, Qc, ksel * MOBA_BLOCK), s_own], axis=-1)
        p = jax.nn.softmax(logits, axis=-1).astype(v.dtype)
        p_sel = p[..., :ksel * MOBA_BLOCK].reshape(B, H, Qc, ksel, MOBA_BLOCK)
        p_own = p[..., ksel * MOBA_BLOCK:]
        return (jnp.einsum('bhqrk,bhqrkd->bhqd', p_sel, v_sel)
                + jnp.einsum('bhqk,bhkd->bhqd', p_own, v_own))

    out = lax.map(chunk, (qc, jnp.arange(nchunk)))
    return out.transpose(1, 2, 0, 3, 4).reshape(B, H, S, dh)


def token_mixer(x, w_in, w_gate, b_gate, w_branch_sb, w_branch_moba, w_out, rel_bias):
    B, S, D = x.shape
    proj = x @ w_in
    cuts = np.cumsum([SB_WIDTH, SB_WIDTH, SB_WIDTH, MOBA_WIDTH, MOBA_WIDTH])
    q_sb, k_sb, v_sb, q_mb, k_mb, v_mb = jnp.split(proj, cuts, axis=-1)

    def heads(t, h):
        return t.reshape(B, S, h, HEAD_DIM).transpose(0, 2, 1, 3)

    def merge(t):
        return t.transpose(0, 2, 1, 3).reshape(B, S, -1)

    o_sb = stick_breaking_attention(heads(q_sb, SB_HEADS), heads(k_sb, SB_HEADS), heads(v_sb, SB_HEADS))
    o_mb = moba_attention(heads(q_mb, MOBA_HEADS), heads(k_mb, MOBA_HEADS), heads(v_mb, MOBA_HEADS), rel_bias)
    y_sb = merge(o_sb) @ w_branch_sb
    y_mb = merge(o_mb) @ w_branch_moba
    gates = jax.nn.sigmoid((x @ w_gate + b_gate).astype(jnp.float32)).astype(x.dtype)
    g_sb, g_mb = jnp.split(gates, 2, axis=-1)
    return (g_sb * y_sb + g_mb * y_mb) @ w_out


def peer_ffn(x, w_peer_query, peer_sub_keys, peer_u, peer_v):
    B, S, D = x.shape
    tokens = x.reshape(-1, D)
    nchunk = tokens.shape[0] // PEER_TOK_CHUNK
    Tc, H, K = PEER_TOK_CHUNK, PEER_HEADS, PEER_TOPK

    def chunk(xc):
        q = (xc @ w_peer_query).reshape(Tc, H, 2, PEER_QDIM // 2)
        s = jnp.einsum('thpd,pnd->thpn', q, peer_sub_keys, preferred_element_type=jnp.float32)
        top_s, top_i = lax.top_k(s, K)
        cand_s = top_s[:, :, 0, :, None] + top_s[:, :, 1, None, :]
        cand_i = top_i[:, :, 0, :, None] * PEER_NKEYS + top_i[:, :, 1, None, :]
        best_s, best_pos = lax.top_k(cand_s.reshape(Tc, H, K * K), K)
        expert = jnp.take_along_axis(cand_i.reshape(Tc, H, K * K), best_pos, axis=-1)
        g = jax.nn.softmax(best_s, axis=-1)
        u = peer_u[expert]
        v = peer_v[expert]
        act = jax.nn.gelu(jnp.einsum('td,thkd->thk', xc, u, preferred_element_type=jnp.float32),
                          approximate=False)
        return jnp.einsum('thk,thkd->td', (g * act).astype(v.dtype), v)

    out = lax.map(chunk, tokens.reshape(nchunk, Tc, D))
    return out.reshape(B, S, D)


def setup_inputs(seed: int = 0) -> dict:
    key = jax.random.key(seed)
    ks = jax.random.split(key, 20)
    D = D_MODEL
    f = jnp.float32
    sd = D ** -0.5
    x = jax.random.normal(ks[0], (BATCH, SEQ, D), f)
    w_qk_sb = jax.random.normal(ks[1], (D, 2 * SB_WIDTH), f) * sd
    w_v_sb = jax.random.normal(ks[2], (D, SB_WIDTH), f) * sd * DN_BETA
    w_qk_mb = jax.random.normal(ks[3], (D, 2 * MOBA_WIDTH), f) * sd
    w_v_mb = jax.random.normal(ks[4], (D, MOBA_WIDTH), f) * sd * DN_BETA
    w_in = jnp.concatenate([w_qk_sb, w_v_sb, w_qk_mb, w_v_mb], axis=1)
    w_gate = jax.random.normal(ks[5], (D, 2 * D), f) * sd
    b_gate = jax.random.normal(ks[6], (2 * D,), f) * 0.01
    w_branch_sb = jax.random.normal(ks[7], (SB_WIDTH, D), f) * SB_WIDTH ** -0.5 * DN_BETA
    w_branch_moba = jax.random.normal(ks[8], (MOBA_WIDTH, D), f) * MOBA_WIDTH ** -0.5 * DN_BETA
    w_out = jax.random.normal(ks[9], (D, D), f) * sd * DN_BETA
    rel_bias = jax.random.normal(ks[10], (MOBA_HEADS, REL_BUCKETS), f) * 0.2
    ln1_g = 1.0 + 0.01 * jax.random.normal(ks[11], (D,), f)
    ln1_b = 0.01 * jax.random.normal(ks[12], (D,), f)
    w_peer_query = jax.random.normal(ks[13], (D, PEER_HEADS * PEER_QDIM), f) * sd
    peer_sub_keys = jax.random.normal(ks[14], (2, PEER_NKEYS, PEER_QDIM // 2), f) * (PEER_QDIM // 2) ** -0.5
    peer_u = jax.random.normal(ks[15], (PEER_N_EXPERTS, D), f) * sd
    peer_v = jax.random.normal(ks[16], (PEER_N_EXPERTS, D), f) * (PEER_HEADS * PEER_TOPK) ** -0.5 * DN_BETA
    ln2_g = 1.0 + 0.01 * jax.random.normal(ks[17], (D,), f)
    ln2_b = 0.01 * jax.random.normal(ks[18], (D,), f)
    return {"x": x, "w_in": w_in, "w_gate": w_gate, "b_gate": b_gate,
            "w_branch_sb": w_branch_sb, "w_branch_moba": w_branch_moba, "w_out": w_out,
            "rel_bias": rel_bias, "ln1_g": ln1_g, "ln1_b": ln1_b,
            "w_peer_query": w_peer_query, "peer_sub_keys": peer_sub_keys,
            "peer_u": peer_u, "peer_v": peer_v, "ln2_g": ln2_g, "ln2_b": ln2_b}


def reference(x, w_in, w_gate, b_gate, w_branch_sb, w_branch_moba, w_out, rel_bias,
              ln1_g, ln1_b, w_peer_query, peer_sub_keys, peer_u, peer_v, ln2_g, ln2_b):
    h = x
    for _ in range(DEPTH):
        mix = token_mixer(h, w_in, w_gate, b_gate, w_branch_sb, w_branch_moba, w_out, rel_bias)
        h = layer_norm(DN_ALPHA * h + mix, ln1_g, ln1_b)
        ffn = peer_ffn(h, w_peer_query, peer_sub_keys, peer_u, peer_v)
        h = layer_norm(DN_ALPHA * h + ffn, ln2_g, ln2_b)
    return h
```

```cpp
#include <hip/hip_runtime.h>
#include <cstdio>
#include <cstdint>
#include <cmath>
namespace pg8 {
#define PG8_LAS __attribute__((address_space(3)))
typedef unsigned short bf16_t;
typedef short bf16x8 __attribute__((ext_vector_type(8)));
typedef float f32x4 __attribute__((ext_vector_type(4)));
typedef unsigned u32x4 __attribute__((ext_vector_type(4)));
constexpr int BM = 256, BK = 64, HALF = 128, HTB = HALF * BK * 2  , STAGE_BYTES = 8 * HTB, NXCD = 8, WGM = 4;

__host__ __device__ __forceinline__ int lds_byte(int r, int c) { const int st = (r >> 4) * 2 + (c >> 5), rr = r & 15, cc = c & 31, ob = rr * 64 + cc * 2; return st * 1024 + (ob ^ (((ob >> 9) & 1) << 5)); }
__host__ __device__ __forceinline__ void stage_rc(int b, int& R, int& C) { const int st = b / 1024, sb = b % 1024, swz = sb ^ (((sb >> 9) & 1) << 5); R = (st >> 1) * 16 + swz / 64; C = (st & 1) * 32 + (swz % 64) / 2; }
__host__ __device__ __forceinline__ int perm32(int rho) { const int n = rho >> 4, i = rho & 15; return 8 * (i >> 2) + 4 * n + (i & 3); }

struct Unit { int pm, pn, src; };
struct Gemm { const bf16_t* A; const bf16_t* Bt; const bf16_t* A1; const bf16_t* Bt1; int M, N, K; };

struct StaticOrder {
    int nM, nN, nwg, G, c;
    __host__ __device__ void init(int M, int N, int G_, int c_) { nM = M / BM; nN = N / BM; nwg = nM * nN; G = G_; c = c_; }
    __host__ __device__ bool next(int i, Unit& u) const {
        const long L = (long)i * G + c; if (L >= nwg) return false;
        int wgid = (int)L; { const int q = nwg / NXCD, r = nwg % NXCD, xcd = wgid % NXCD, off = wgid / NXCD; wgid = (xcd < r ? xcd * (q + 1) : r * (q + 1) + (xcd - r) * q) + off; }
        const int nig = WGM * nN, gid = wgid / nig, fm = gid * WGM, gsz = (nM - fm) < WGM ? (nM - fm) : WGM;
        u.pm = fm + ((wgid % nig) % gsz); u.pn = (wgid % nig) / gsz; u.src = 0; return true;
    }
    __device__ __forceinline__ void a_ready(const Unit&) const {}
    __device__ __forceinline__ void done(const Unit&) const {}
};

__device__ __forceinline__ unsigned cvt_pk_bf16(float lo, float hi) { unsigned r; asm volatile("v_cvt_pk_bf16_f32 %0, %1, %2" : "=v"(r) : "v"(lo), "v"(hi)); return r; }
typedef float f32x2 __attribute__((ext_vector_type(2)));
__device__ __forceinline__ f32x2 gelu_pk(f32x2 v) {
    const f32x2 av = __builtin_elementwise_abs(v), d = av * 0.2316418882f + 1.0f;
    f32x2 t; t.x = __builtin_amdgcn_rcpf(d.x); t.y = __builtin_amdgcn_rcpf(d.y);
    f32x2 q = t * 0.5307027145f + (-0.7265760135f); q = q * t + 0.7107068705f; q = q * t + (-0.142248368f); q = q * t + 0.127414796f; q = q * t;
    const f32x2 s = (v * v) * (-0.72134752044f);
    f32x2 e; e.x = __builtin_amdgcn_exp2f(s.x); e.y = __builtin_amdgcn_exp2f(s.y);
    const f32x2 m = v * (q * e), r = v - m;
    f32x2 o; o.x = v.x < 0.f ? m.x : r.x; o.y = v.y < 0.f ? m.y : r.y; return o;
}

__device__ __forceinline__ float bf2f(unsigned short b) { return __uint_as_float((unsigned)b << 16); }
__device__ __forceinline__ float bflo(unsigned w) { return __uint_as_float(w << 16); }
__device__ __forceinline__ float bfhi(unsigned w) { return __uint_as_float(w & 0xffff0000u); }
__device__ __forceinline__ float sigmoid_fast(float v) { return __builtin_amdgcn_rcpf(1.0f + __builtin_amdgcn_exp2f(-1.4426950408889634f * v)); }

struct EpiQkvGate {
    static constexpr bool PERM = true, AFTER_DRAIN = false;
    bf16_t* QKV; bf16_t* GATE; const float* bgate; float oscale;
    __device__ __forceinline__ bool keep(const Unit&) const { return false; }
    __device__ __forceinline__ void operator()(f32x4 (&acc)[2][2][4][2], const Unit& u, int wr, int wc, int fr, int fq) const {
        const int row0 = u.pm * BM + wr * 64 + fr; const int colt = u.pn * BM;
        const bool isgate = colt >= 6144;
        bf16_t* base = isgate ? GATE : QKV + (size_t)(colt >> 7) * 16384 * 128; const int ldc = isgate ? 4096 : 128; const int cb = isgate ? colt - 6144 : 0;
        const size_t hstep = isgate ? (size_t)HALF : (size_t)16384 * 128;
        const int col0 = cb + wc * 32 + 8 * fq;
        f32x4 bv[2][2];
#pragma unroll
        for (int bj = 0; bj < 2; ++bj)
#pragma unroll
            for (int n = 0; n < 2; ++n) bv[bj][n] = isgate ? *(const f32x4*)(bgate + col0 + bj * HALF + 4 * n) : (f32x4){0.f, 0.f, 0.f, 0.f};
#pragma unroll
        for (int ai = 0; ai < 2; ++ai)
#pragma unroll
            for (int m = 0; m < 4; ++m) { bf16_t* rowp = base + (size_t)(row0 + ai * HALF + m * 16) * ldc + col0;
#pragma unroll
                for (int bj = 0; bj < 2; ++bj) { f32x4 v0 = acc[ai][bj][m][0] * oscale + bv[bj][0], v1 = acc[ai][bj][m][1] * oscale + bv[bj][1];
                    if (isgate) {
#pragma unroll
                        for (int i = 0; i < 4; ++i) { v0[i] = sigmoid_fast(v0[i]); v1[i] = sigmoid_fast(v1[i]); } }
                    u32x4 w; w.x = cvt_pk_bf16(v0[0], v0[1]); w.y = cvt_pk_bf16(v0[2], v0[3]); w.z = cvt_pk_bf16(v1[0], v1[1]); w.w = cvt_pk_bf16(v1[2], v1[3]);
                    *(u32x4*)(rowp + bj * hstep) = w; } }
    }
};

struct EpiBranch {
    static constexpr bool PERM = true, AFTER_DRAIN = false;
    const bf16_t* GATE; bf16_t* MIXED;
    __device__ __forceinline__ bool keep(const Unit& u) const { return u.src == 0; }
    __device__ __forceinline__ void operator()(f32x4 (&acc)[2][2][4][2], const Unit& u, int wr, int wc, int fr, int fq) const {
        const int row0 = u.pm * BM + wr * 64 + fr; const int col0 = u.pn * BM + wc * 32 + 8 * fq;
#pragma unroll
        for (int ai = 0; ai < 2; ++ai)
#pragma unroll
            for (int m = 0; m < 4; ++m) { const size_t r = (size_t)(row0 + ai * HALF + m * 16);
#pragma unroll
                for (int bj = 0; bj < 2; ++bj) {
                    const u32x4 gm = *(const u32x4*)(GATE + r * 4096 + 2048 + col0 + bj * HALF);
                    float m_[8] = {bflo(gm.x), bfhi(gm.x), bflo(gm.y), bfhi(gm.y), bflo(gm.z), bfhi(gm.z), bflo(gm.w), bfhi(gm.w)};
#pragma unroll
                    for (int i = 0; i < 8; ++i) m_[i] = fmaxf(m_[i], 1e-30f);
                    if (u.src == 0) {
                        const u32x4 gs = *(const u32x4*)(GATE + r * 4096 + col0 + bj * HALF);
                        const float s_[8] = {bflo(gs.x), bfhi(gs.x), bflo(gs.y), bfhi(gs.y), bflo(gs.z), bfhi(gs.z), bflo(gs.w), bfhi(gs.w)};
#pragma unroll
                        for (int i = 0; i < 4; ++i) { acc[ai][bj][m][0][i] *= s_[i] * __builtin_amdgcn_rcpf(m_[i]); acc[ai][bj][m][1][i] *= s_[4 + i] * __builtin_amdgcn_rcpf(m_[4 + i]); }
                    } else {
                        f32x4 v0 = acc[ai][bj][m][0], v1 = acc[ai][bj][m][1];
#pragma unroll
                        for (int i = 0; i < 4; ++i) { v0[i] *= m_[i]; v1[i] *= m_[4 + i]; }
                        int w0 = 0, w1 = 0;
                        w0 = __builtin_amdgcn_cvt_pk_fp8_f32(fminf(fmaxf(v0[0], -448.f), 448.f), fminf(fmaxf(v0[1], -448.f), 448.f), w0, false); w0 = __builtin_amdgcn_cvt_pk_fp8_f32(fminf(fmaxf(v0[2], -448.f), 448.f), fminf(fmaxf(v0[3], -448.f), 448.f), w0, true);
                        w1 = __builtin_amdgcn_cvt_pk_fp8_f32(fminf(fmaxf(v1[0], -448.f), 448.f), fminf(fmaxf(v1[1], -448.f), 448.f), w1, false); w1 = __builtin_amdgcn_cvt_pk_fp8_f32(fminf(fmaxf(v1[2], -448.f), 448.f), fminf(fmaxf(v1[3], -448.f), 448.f), w1, true);
                        typedef unsigned pg8_u32x2 __attribute__((ext_vector_type(2)));
                        *(pg8_u32x2*)((unsigned char*)MIXED + r * 2048 + col0 + bj * HALF) = (pg8_u32x2){(unsigned)w0, (unsigned)w1}; } } }
    }
};

struct EpiF32 {
    static constexpr bool PERM = false, AFTER_DRAIN = false;
    float* out; const float* res; float alpha; int ldc; float oscale;
    __device__ __forceinline__ bool keep(const Unit&) const { return false; }
    __device__ __forceinline__ void operator()(f32x4 (&acc)[2][2][4][2], const Unit& u, int wr, int wc, int fr, int fq) const {
        const int row0 = u.pm * BM + wr * 64 + fr; const int col0 = u.pn * BM + wc * 32 + 4 * fq;
#pragma unroll
        for (int ai = 0; ai < 2; ++ai)
#pragma unroll
            for (int m = 0; m < 4; ++m) { const size_t off = (size_t)(row0 + ai * HALF + m * 16) * ldc + col0;
#pragma unroll
                for (int bj = 0; bj < 2; ++bj)
#pragma unroll
                    for (int n = 0; n < 2; ++n) { f32x4 v = acc[ai][bj][m][n] * oscale;
                        if (res) { const f32x4 x = *(const f32x4*)(res + off + bj * HALF + n * 16); v = v + x * alpha; }
                        *(f32x4*)(out + off + bj * HALF + n * 16) = v; } }
    }
};

struct EpiBf16 {
    static constexpr bool PERM = true, AFTER_DRAIN = false;
    bf16_t* O; int ldc;
    __device__ __forceinline__ bool keep(const Unit&) const { return false; }
    __device__ __forceinline__ void operator()(f32x4 (&acc)[2][2][4][2], const Unit& u, int wr, int wc, int fr, int fq) const {
        const int row0 = u.pm * BM + wr * 64 + fr; const int col0 = u.pn * BM + wc * 32 + 8 * fq;
#pragma unroll
        for (int ai = 0; ai < 2; ++ai)
#pragma unroll
            for (int m = 0; m < 4; ++m) { bf16_t* rowp = O + (size_t)(row0 + ai * HALF + m * 16) * ldc + col0;
#pragma unroll
                for (int bj = 0; bj < 2; ++bj) { const f32x4 v0 = acc[ai][bj][m][0], v1 = acc[ai][bj][m][1];
                    u32x4 w; w.x = cvt_pk_bf16(v0[0], v0[1]); w.y = cvt_pk_bf16(v0[2], v0[3]); w.z = cvt_pk_bf16(v1[0], v1[1]); w.w = cvt_pk_bf16(v1[2], v1[3]);
                    *(u32x4*)(rowp + bj * HALF) = w; } }
    }
};

struct DualOrder {
    StaticOrder so;
    __host__ __device__ void init(int M, int N, int G_, int c_) { so.init(M, N, G_, c_); }
    __host__ __device__ bool next(int i, Unit& u) const { if (!so.next(i >> 1, u)) return false; u.src = i & 1; return true; }
    __device__ __forceinline__ void a_ready(const Unit&) const {}
    __device__ __forceinline__ void done(const Unit&) const {}
};


typedef int pg8_i32x4 __attribute__((ext_vector_type(4)));
typedef int pg8_i32x8 __attribute__((ext_vector_type(8)));
template <class Epi, class Sched, bool ALIGN_EPI = false, bool SP2 = false, bool F8 = false>
__device__ __forceinline__ void gemm_phase(PG8_LAS unsigned char* lds, const Gemm g, const Sched& S, const Epi& E) {
    int tid_ = threadIdx.x; asm volatile("" : "+v"(tid_));
    const int tid = tid_, wid = __builtin_amdgcn_readfirstlane(tid >> 6), lane = tid & 63, wr = wid >> 2, wc = wid & 3, fr = lane & 15, fq = lane >> 4;
    const int K = g.K, nt = K / BK;
    unsigned voffA[2], voffB[2];
#pragma unroll
    for (int i = 0; i < 2; ++i) { int R, C; stage_rc(tid * 16 + i * 8192, R, C); const int Rb = Epi::PERM ? ((R & ~31) + perm32(R & 31)) : R;
        voffA[i] = (unsigned)(R * K + C) * 2u; voffB[i] = (unsigned)(Rb * K + C) * 2u; }
    const size_t kstep = (size_t)(BK * 2);
    const size_t hstep = (size_t)HALF * K * 2;
    const size_t tstep = 2 * hstep;
    const unsigned ldsw = (unsigned)wid * 1024u;
    const int aoff = lds_byte(wr * 64 + fr, fq * 8), boff = lds_byte(wc * 32 + fr, fq * 8);
#define PG8_SA(b, h) (((b) * 2 + (h)) * HTB)
#define PG8_SB(b, h) ((4 + (b) * 2 + (h)) * HTB)
#define PG8_STAGE(bufoff, gbase, voff) do { _Pragma("unroll") for (int _i = 0; _i < 2; ++_i) { unsigned vo_ = (voff)[_i]; asm volatile("" : "+v"(vo_));     \
        __builtin_amdgcn_global_load_lds((const unsigned*)((const char*)(gbase) + vo_), (PG8_LAS unsigned*)(lds + (bufoff) + ldsw + _i * 8192), 16, 0, 0); } } while (0)
#define PG8_LD8(dst8, addr) do { const pg8_i32x4 lo_ = *(const PG8_LAS pg8_i32x4*)(addr), hi_ = *(const PG8_LAS pg8_i32x4*)((addr) + 1024); dst8 = (pg8_i32x8){lo_.x, lo_.y, lo_.z, lo_.w, hi_.x, hi_.y, hi_.z, hi_.w}; } while (0)
#define PG8_LDA(dst, b, h) do { if constexpr (F8) { _Pragma("unroll") for (int m = 0; m < 4; ++m) PG8_LD8(dst##8[m], lds + PG8_SA(b, h) + aoff + m * 2048); } \
        else { _Pragma("unroll") for (int m = 0; m < 4; ++m) _Pragma("unroll") for (int k = 0; k < 2; ++k) dst[m][k] = *(const PG8_LAS bf16x8*)(lds + PG8_SA(b, h) + aoff + m * 2048 + k * 1024); } } while (0)
#define PG8_LDB(dst, b, h) do { if constexpr (F8) { _Pragma("unroll") for (int n = 0; n < 2; ++n) PG8_LD8(dst##8[n], lds + PG8_SB(b, h) + boff + n * 2048); } \
        else { _Pragma("unroll") for (int n = 0; n < 2; ++n) _Pragma("unroll") for (int k = 0; k < 2; ++k) dst[n][k] = *(const PG8_LAS bf16x8*)(lds + PG8_SB(b, h) + boff + n * 2048 + k * 1024); } } while (0)
#define PG8_MMA(ai, bj, At, Bt) do { __builtin_amdgcn_s_setprio(1); _Pragma("unroll") for (int m = 0; m < 4; ++m) _Pragma("unroll") for (int n = 0; n < 2; ++n) { \
        if constexpr (F8) acc[ai][bj][m][n] = __builtin_amdgcn_mfma_scale_f32_16x16x128_f8f6f4(Bt##8[n], At##8[m], acc[ai][bj][m][n], 0, 0, 0, 0, 0, 0); \
        else { _Pragma("unroll") for (int k = 0; k < 2; ++k) acc[ai][bj][m][n] = __builtin_amdgcn_mfma_f32_16x16x32_bf16(Bt[n][k], At[m][k], acc[ai][bj][m][n], 0, 0, 0); } } \
        __builtin_amdgcn_s_setprio(0); } while (0)
#define PG8_WAIT_V(n) asm volatile("s_waitcnt vmcnt(" #n ")" ::: "memory")
#define PG8_WAIT_L(n) asm volatile("s_waitcnt lgkmcnt(" #n ")" ::: "memory")
#define PG8_BAR __builtin_amdgcn_s_barrier()
#define PG8_SCHED __builtin_amdgcn_sched_barrier(0)
    Unit cur, nxt; int ui = 0;
    if (!S.next(0, cur)) return;
    f32x4 acc[2][2][4][2];
#pragma unroll
    for (int a = 0; a < 2; ++a)
#pragma unroll
        for (int b = 0; b < 2; ++b)
#pragma unroll
            for (int m = 0; m < 4; ++m)
#pragma unroll
                for (int n = 0; n < 2; ++n) acc[a][b][m][n] = (f32x4){0.f, 0.f, 0.f, 0.f};
    bf16x8 At[4][2], B0[2][2], B1[2][2]; pg8_i32x8 At8[4], B08[2], B18[2];
    const char* cA = (const char*)(cur.src ? g.A1 : g.A) + (size_t)cur.pm * tstep; const char* cB = (const char*)(cur.src ? g.Bt1 : g.Bt) + (size_t)cur.pn * tstep;
    S.a_ready(cur);
    if constexpr (SP2) {
        PG8_STAGE(PG8_SB(0, 0), cB, voffB); PG8_STAGE(PG8_SB(0, 1), cB + hstep, voffB); PG8_STAGE(PG8_SA(0, 0), cA, voffA); PG8_STAGE(PG8_SA(0, 1), cA + hstep, voffA);
        if (wr == 1) PG8_BAR;
        PG8_WAIT_V(2); PG8_BAR;
        PG8_STAGE(PG8_SB(1, 0), cB + kstep, voffB); PG8_STAGE(PG8_SA(1, 0), cA + kstep, voffA); PG8_STAGE(PG8_SB(1, 1), cB + hstep + kstep, voffB);
        PG8_WAIT_V(6); PG8_BAR;
    } else {
        PG8_STAGE(PG8_SB(0, 0), cB, voffB); PG8_STAGE(PG8_SA(0, 0), cA, voffA); PG8_STAGE(PG8_SB(0, 1), cB + hstep, voffB); PG8_STAGE(PG8_SA(0, 1), cA + hstep, voffA);
        if (wr == 1) PG8_BAR;
        PG8_WAIT_V(4); PG8_BAR;
        PG8_STAGE(PG8_SB(1, 0), cB + kstep, voffB); PG8_STAGE(PG8_SA(1, 0), cA + kstep, voffA); PG8_STAGE(PG8_SB(1, 1), cB + hstep + kstep, voffB);
        PG8_WAIT_V(6); PG8_BAR;
    }
    for (;;) {
        const bool has_next = S.next(ui + 1, nxt);
        const char* nA = has_next ? (const char*)(nxt.src ? g.A1 : g.A) + (size_t)nxt.pm * tstep : cA; const char* nB = has_next ? (const char*)(nxt.src ? g.Bt1 : g.Bt) + (size_t)nxt.pn * tstep : cB;
        for (int t = 0; t < nt; t += 2) {
            const bool last = (t == nt - 2);
            const char* a1 = cA + (size_t)(t + 1) * kstep;
            const char* a2 = last ? nA : cA + (size_t)(t + 2) * kstep; const char* b2 = last ? nB : cB + (size_t)(t + 2) * kstep;
            const char* a3 = a2 + kstep; const char* b3 = b2 + kstep;
            if (last && has_next) S.a_ready(nxt);
            if constexpr (SP2) {
            PG8_LDB(B0, 0, 0); PG8_LDB(B1, 0, 1); PG8_SCHED; PG8_LDA(At, 0, 0); PG8_STAGE(PG8_SA(1, 1), a1 + hstep, voffA);
            PG8_WAIT_V(8); PG8_WAIT_L(0); PG8_BAR; PG8_MMA(0, 0, At, B0); PG8_MMA(0, 1, At, B1); PG8_BAR; PG8_SCHED;
            PG8_LDA(At, 0, 1); PG8_STAGE(PG8_SB(0, 0), b2, voffB); PG8_STAGE(PG8_SB(0, 1), b2 + hstep, voffB); PG8_STAGE(PG8_SA(0, 0), a2, voffA);
            PG8_WAIT_V(8); PG8_WAIT_L(0); PG8_BAR; PG8_MMA(1, 0, At, B0); PG8_MMA(1, 1, At, B1); PG8_BAR; PG8_SCHED;
            PG8_LDB(B0, 1, 0); PG8_LDB(B1, 1, 1); PG8_SCHED; PG8_LDA(At, 1, 0); PG8_STAGE(PG8_SA(0, 1), a2 + hstep, voffA);
            PG8_WAIT_V(8); PG8_WAIT_L(0); PG8_BAR; PG8_MMA(0, 0, At, B0); PG8_MMA(0, 1, At, B1); PG8_BAR; PG8_SCHED;
            PG8_LDA(At, 1, 1); PG8_STAGE(PG8_SB(1, 0), b3, voffB); PG8_STAGE(PG8_SB(1, 1), b3 + hstep, voffB); PG8_STAGE(PG8_SA(1, 0), a3, voffA);
            PG8_WAIT_V(8); PG8_WAIT_L(0); PG8_BAR; PG8_MMA(1, 0, At, B0); PG8_MMA(1, 1, At, B1); PG8_BAR; PG8_SCHED;
            } else {
            PG8_LDB(B0, 0, 0); PG8_SCHED; PG8_LDA(At, 0, 0); PG8_STAGE(PG8_SA(1, 1), a1 + hstep, voffA);
            PG8_WAIT_L(8); PG8_BAR; PG8_WAIT_L(0); PG8_MMA(0, 0, At, B0); PG8_BAR; PG8_SCHED;
            PG8_LDB(B1, 0, 1); PG8_STAGE(PG8_SB(0, 0), b2, voffB);
            PG8_BAR; PG8_WAIT_L(0); PG8_MMA(0, 1, At, B1); PG8_BAR;
            PG8_LDA(At, 0, 1); PG8_STAGE(PG8_SA(0, 0), a2, voffA);
            PG8_BAR; PG8_WAIT_L(0); PG8_MMA(1, 0, At, B0); PG8_BAR; PG8_SCHED;
            PG8_STAGE(PG8_SB(0, 1), b2 + hstep, voffB);
            PG8_WAIT_V(6); PG8_BAR; PG8_MMA(1, 1, At, B1); PG8_BAR;
            PG8_LDB(B0, 1, 0); PG8_SCHED; PG8_LDA(At, 1, 0); PG8_STAGE(PG8_SA(0, 1), a2 + hstep, voffA);
            PG8_WAIT_L(8); PG8_BAR; PG8_WAIT_L(0); PG8_MMA(0, 0, At, B0); PG8_BAR; PG8_SCHED;
            PG8_LDB(B1, 1, 1); PG8_STAGE(PG8_SB(1, 0), b3, voffB);
            PG8_BAR; PG8_WAIT_L(0); PG8_MMA(0, 1, At, B1); PG8_BAR;
            PG8_LDA(At, 1, 1); PG8_STAGE(PG8_SA(1, 0), a3, voffA);
            PG8_BAR; PG8_WAIT_L(0); PG8_MMA(1, 0, At, B0); PG8_BAR; PG8_SCHED;
            PG8_STAGE(PG8_SB(1, 1), b3 + hstep, voffB);
            PG8_WAIT_V(6); PG8_BAR; PG8_MMA(1, 1, At, B1); PG8_BAR;
            }
        }
        if constexpr (ALIGN_EPI) { if (wr == 0) PG8_BAR; }
        if constexpr (!Epi::AFTER_DRAIN) { E(acc, cur, wr, wc, fr, fq); S.done(cur); }
        if (!has_next) break;
        if (!E.keep(cur)) {
#pragma unroll
        for (int a = 0; a < 2; ++a)
#pragma unroll
            for (int b = 0; b < 2; ++b)
#pragma unroll
                for (int m = 0; m < 4; ++m)
#pragma unroll
                    for (int n = 0; n < 2; ++n) acc[a][b][m][n] = (f32x4){0.f, 0.f, 0.f, 0.f};
        }
        cur = nxt; cA = nA; cB = nB; ++ui;
        if constexpr (ALIGN_EPI) { if (wr == 1) PG8_BAR; }
    }
    PG8_WAIT_V(0);
    if constexpr (!ALIGN_EPI) { if (wr == 0) PG8_BAR; }
    PG8_BAR;
    if constexpr (Epi::AFTER_DRAIN) { E.fused(acc, cur, wr, wc, fr, fq, lds, wid, lane); S.done(cur); }
#undef PG8_SA
#undef PG8_SB
#undef PG8_STAGE
#undef PG8_LDA
#undef PG8_LDB
#undef PG8_MMA
#undef PG8_WAIT_V
#undef PG8_WAIT_L
#undef PG8_BAR
#undef PG8_SCHED
}
}

#ifndef PG8_SP2
#define PG8_SP2 true
#endif
#ifndef PG8_ALIGN
#define PG8_ALIGN true
#endif
constexpr int NWAVES = 8;
constexpr int N_PHASES = 10;
#ifndef MK_N_LAUNCHES
#define MK_N_LAUNCHES 1
#endif
constexpr int N_LAUNCHES = MK_N_LAUNCHES;
static_assert(N_LAUNCHES == 1 || N_LAUNCHES == N_PHASES, "MK_N_LAUNCHES is 1 or N_PHASES");

constexpr int BATCH = 2, SEQ = 8192, D = 2048, M = BATCH * SEQ;
constexpr int NH = 8, HD = 128, HW = NH * HD;
constexpr int NQKV = 6 * HW, NGATE = 2 * D, N1 = NQKV + NGATE;
constexpr int S_QSB = 0, S_KSB = 1, S_VSB = 2, S_QMB = 3, S_KMB = 4, S_VMB = 5;
constexpr int MB_BLK = 256, MB_NB = SEQ / MB_BLK;
constexpr int PEER_H = 8, PEER_NK = 128, PEER_K = 16, PEER_QD = 256, PEER_SEL = PEER_H * PEER_K;
constexpr float LN_EPS = 1e-5f;
constexpr float DN_ALPHA = 1.189207115002721f;
constexpr float ATT_SCALE = 0.08838834764831845f;
constexpr float LOG2E = 1.4426950408889634f;
constexpr float SB_EXIT = 1e-12f;

constexpr size_t MiB = 1u << 20;
constexpr size_t WS_CTL = 0, CTL_ZERO_BYTES = 1 * MiB;
constexpr size_t WS_KMEAN = 1 * MiB;
constexpr size_t WS_WIG = 2 * MiB;
constexpr size_t WS_WSB = 42 * MiB, WS_WMB = 46 * MiB;
constexpr size_t WS_WOUT = 50 * MiB, WS_WPQ = 58 * MiB;
constexpr size_t WS_IDS = 66 * MiB, WS_GW = 74 * MiB;
constexpr size_t WS_QKV = 96 * MiB;
constexpr size_t WS_H1 = 96 * MiB;
constexpr size_t WS_MIXED = 224 * MiB;
constexpr size_t WS_GATE = 288 * MiB;
constexpr size_t WS_QP = 288 * MiB;
constexpr size_t WS_XB = 416 * MiB;
constexpr size_t WS_OSB = 416 * MiB, WS_OMB = 448 * MiB;
constexpr size_t WS_X1B = 416 * MiB;
constexpr size_t WS_U8 = 224 * MiB, WS_V8 = 256 * MiB;
constexpr size_t WS_END = 480 * MiB;
constexpr int CW_BAR = 4096;

constexpr int RING_OFF = 0, RING_BYTES = 131072;
constexpr int LDSCTL_OFF = RING_BYTES, MISC_OFF = LDSCTL_OFF + 320;
constexpr int P9X_OFF = 147456;
constexpr int LDS_BYTES = 163840;
static_assert(MISC_OFF + 128 <= LDS_BYTES, "LDS map");

#define GAS __attribute__((address_space(1)))
#define LAS __attribute__((address_space(3)))
typedef unsigned short bf16;
typedef unsigned v4u __attribute__((ext_vector_type(4)));
typedef unsigned v2u __attribute__((ext_vector_type(2)));
typedef float f32x4 __attribute__((ext_vector_type(4)));
typedef float f32x2 __attribute__((ext_vector_type(2)));
typedef GAS unsigned gu32;
#define RLX_AGENT __ATOMIC_RELAXED, __HIP_MEMORY_SCOPE_AGENT
#define LDS_WAIT() asm volatile("s_waitcnt lgkmcnt(0)" ::: "memory")
#define VM_WAIT() asm volatile("s_waitcnt vmcnt(0)" ::: "memory")
__device__ __forceinline__ unsigned f2bf(float f) { unsigned u = __builtin_bit_cast(unsigned, f); return (u + 0x7fffu + ((u >> 16) & 1u)) >> 16; }
__device__ __forceinline__ unsigned pk2(float lo, float hi) { return f2bf(lo) | (f2bf(hi) << 16); }
__device__ __forceinline__ float bflo(unsigned w) { return __uint_as_float(w << 16); }
__device__ __forceinline__ float bfhi(unsigned w) { return __uint_as_float(w & 0xffff0000u); }

#define XB_TMO      128
#define XB_XCNT(j)  (256  + 64 * (j))
#define XB_XSUB(j)  (1280 + 64 * (j))
#define XB_XGEN(j)  (2304 + 64 * (j))
#define XB_TOP      3328
#define XB_TOPGEN   3392
#define XCD_BAR_WORDS 3456
#define XB_SPIN_CAP (1u << 18)

__device__ __forceinline__ unsigned xb_ld(unsigned* p)              { return __hip_atomic_load(p, __ATOMIC_RELAXED, __HIP_MEMORY_SCOPE_AGENT); }
__device__ __forceinline__ unsigned xb_add(unsigned* p, unsigned v) { return __hip_atomic_fetch_add(p, v, __ATOMIC_RELAXED, __HIP_MEMORY_SCOPE_AGENT); }
__device__ __forceinline__ unsigned xb_xcc_id() { return (unsigned)__builtin_amdgcn_s_getreg((3 << 11) | 20) & 0xFu; }
#define XB_SPIN(cond, bar) do { unsigned _sp = 0; while (cond) { __builtin_amdgcn_s_sleep(1); \
    if ((++_sp & 255u) == 0u) { if (xb_ld(&(bar)[XB_TMO])) break; if (_sp > XB_SPIN_CAP) { atomicAdd(&(bar)[XB_TMO], 1u); break; } } } } while (0)

struct XcdBarrier {
    unsigned* bar; unsigned x;
    volatile LAS unsigned* st;
};
__device__ __forceinline__ XcdBarrier xcd_barrier_post(unsigned* bar, volatile LAS unsigned* st) {
    XcdBarrier b; b.bar = bar; b.x = xb_xcc_id(); b.st = st;
    if (threadIdx.x == 0) (void)xb_add(&bar[XB_XCNT(b.x)], 1u);
    return b;
}
__device__ __forceinline__ void xcd_barrier_complete(unsigned* bar, unsigned x, unsigned& nloc, unsigned& nx) {
    const unsigned G = gridDim.x * gridDim.y * gridDim.z;
    unsigned sum, cnt, mine, sp = 0u;
    for (;;) {
        sum = 0u; cnt = 0u; mine = 0u;
#pragma unroll
        for (unsigned j = 0; j < 16; ++j) { const unsigned c = xb_ld(&bar[XB_XCNT(j)]); sum += c; cnt += (c > 0u) ? 1u : 0u; mine = (j == x) ? c : mine; }
        if (sum == G) break;
        __builtin_amdgcn_s_sleep(1);
        if ((++sp & 255u) == 0u) { if (xb_ld(&bar[XB_TMO])) break; if (sp > XB_SPIN_CAP) { atomicAdd(&bar[XB_TMO], 1u); break; } }
    }
    nloc = mine > 0u ? mine : 1u; nx = cnt > 0u ? cnt : 1u;
}
__device__ __forceinline__ void xcd_barrier(const XcdBarrier& b) {
    asm volatile("s_waitcnt vmcnt(0)" ::: "memory");
    __syncthreads();
    if (threadIdx.x == 0) {
        unsigned* bar = b.bar;
        __builtin_amdgcn_s_waitcnt(0);
        unsigned nloc = b.st[0], nx = b.st[1];
        if (nloc == 0u) { xcd_barrier_complete(bar, b.x, nloc, nx); b.st[0] = nloc; b.st[1] = nx; }
        const unsigned old = xb_add(&bar[XB_XSUB(b.x)], 1u);
        const unsigned gen = old / nloc;
        if (old + 1u == (gen + 1u) * nloc) {
            __builtin_amdgcn_fence(__ATOMIC_RELEASE, "agent");
            asm volatile("s_waitcnt vmcnt(0)" ::: "memory");
            const unsigned og = xb_add(&bar[XB_TOP], 1u);
            const unsigned tg = og / nx;
            if (og + 1u == (tg + 1u) * nx) xb_add(&bar[XB_TOPGEN], 1u);
            else XB_SPIN(xb_ld(&bar[XB_TOPGEN]) == tg, bar);
            __builtin_amdgcn_fence(__ATOMIC_ACQUIRE, "agent");
            xb_add(&bar[XB_XGEN(b.x)], 1u);
            asm volatile("s_waitcnt vmcnt(0)" ::: "memory");
        } else {
            XB_SPIN(xb_ld(&bar[XB_XGEN(b.x)]) == gen, bar);
            __builtin_amdgcn_fence(__ATOMIC_ACQUIRE, "agent");
            asm volatile("s_waitcnt vmcnt(0)" ::: "memory");
        }
    }
    __syncthreads();
}

struct Frame {
    LAS unsigned char* lds;
    volatile LAS unsigned* MISC;
    gu32* ctl;
    int tid, lane, wave;
    int vcu, G;
    const float *x, *w_in, *w_gate, *b_gate, *w_bsb, *w_bmb, *w_out, *rel_bias, *ln1_g, *ln1_b, *w_pq, *subkeys, *peer_u, *peer_v, *ln2_g, *ln2_b;
    float* out;
    float* KMEAN; bf16 *WIG, *WSB, *WMB, *WOUT, *WPQ; int* IDS; float* GW;
    bf16 *QKV, *MIXED, *GATE, *XB, *OSB, *OMB, *X1B, *QPB; float *H1, *QP; unsigned char *U8, *V8;
};

__device__ __forceinline__ float wave_sum(float v) {
#pragma unroll
    for (int o = 1; o < 64; o <<= 1) v += __shfl_xor(v, o);
    return v;
}
__device__ __forceinline__ float wave_max(float v) {
#pragma unroll
    for (int o = 1; o < 64; o <<= 1) v = fmaxf(v, __shfl_xor(v, o));
    return v;
}
__device__ __forceinline__ void wave_argmax(float& v, int& i) {
#pragma unroll
    for (int o = 1; o < 64; o <<= 1) { const float ov = __shfl_xor(v, o); const int oi = __shfl_xor(i, o); if (ov > v || (ov == v && oi < i)) { v = ov; i = oi; } }
}

__device__ __forceinline__ void p0_transpose_item(const float* W, int K, int N, bf16* WT, int row_off, LAS float* scr, int item, int lane) {
    const int nblk = N / 32, kb = item / nblk, nb = item % nblk, k0 = 64 * kb, n0 = 32 * nb;
    float tv[32];
#pragma unroll
    for (int i = 0; i < 32; ++i) { const int kk = 2 * i + (lane >> 5); tv[i] = W[(size_t)(k0 + kk) * N + n0 + (lane & 31)]; }
#pragma unroll
    for (int i = 0; i < 32; ++i) { const int kk = 2 * i + (lane >> 5); scr[kk * 33 + (lane & 31)] = tv[i]; }
    LDS_WAIT(); asm volatile("" ::: "memory");
    const int c = lane & 7;
#pragma unroll
    for (int j = 0; j < 4; ++j) { const int n = (lane >> 3) + 8 * j; const LAS float* s = scr + (8 * c) * 33 + n;
        v4u o; o.x = pk2(s[0 * 33], s[1 * 33]); o.y = pk2(s[2 * 33], s[3 * 33]); o.z = pk2(s[4 * 33], s[5 * 33]); o.w = pk2(s[6 * 33], s[7 * 33]);
        *(GAS v4u*)(WT + (size_t)(row_off + n0 + n) * K + k0 + 8 * c) = o; }
    LDS_WAIT(); asm volatile("" ::: "memory");
}
constexpr float W8_SCALE = 64.f;
__device__ __forceinline__ unsigned pk4_fp8(float a, float b, float c, float d) {
    int w = 0; w = __builtin_amdgcn_cvt_pk_fp8_f32(fminf(fmaxf(a, -448.f), 448.f), fminf(fmaxf(b, -448.f), 448.f), w, false);
    w = __builtin_amdgcn_cvt_pk_fp8_f32(fminf(fmaxf(c, -448.f), 448.f), fminf(fmaxf(d, -448.f), 448.f), w, true); return (unsigned)w; }
__device__ __forceinline__ void p0_transpose_item8(const float* W, int K, int N, unsigned char* WT, int row_off, LAS float* scr, int item, int lane) {
    const int nblk = N / 32, kb = item / nblk, nb = item % nblk, k0 = 64 * kb, n0 = 32 * nb;
    float tv[32];
#pragma unroll
    for (int i = 0; i < 32; ++i) { const int kk = 2 * i + (lane >> 5); tv[i] = W[(size_t)(k0 + kk) * N + n0 + (lane & 31)]; }
#pragma unroll
    for (int i = 0; i < 32; ++i) { const int kk = 2 * i + (lane >> 5); scr[kk * 33 + (lane & 31)] = tv[i] * W8_SCALE; }
    LDS_WAIT(); asm volatile("" ::: "memory");
    const int c = lane & 7;
#pragma unroll
    for (int j = 0; j < 4; ++j) { const int n = (lane >> 3) + 8 * j; const LAS float* s = scr + (8 * c) * 33 + n;
        v2u o; o.x = pk4_fp8(s[0 * 33], s[1 * 33], s[2 * 33], s[3 * 33]); o.y = pk4_fp8(s[4 * 33], s[5 * 33], s[6 * 33], s[7 * 33]);
        *(GAS v2u*)(WT + (size_t)(row_off + n0 + n) * K + k0 + 8 * c) = o; }
    LDS_WAIT(); asm volatile("" ::: "memory");
}
__device__ __forceinline__ void p0_prologue(Frame& F) {
    LAS float* scr = (LAS float*)(F.lds + RING_OFF + F.wave * 16384);
    const int gw = F.vcu * NWAVES + F.wave, NGW = F.G * NWAVES;
    constexpr int I_IN = (D / 64) * (NQKV / 32), I_G = (D / 64) * (NGATE / 32), I_B = (HW / 64) * (D / 32), I_O = (D / 64) * (D / 32);
    constexpr int NITEMS = I_IN + I_G + 2 * I_B + 2 * I_O;
    for (int it = gw; it < NITEMS; it += NGW) {
        int r = it;
        if (r < I_IN) { p0_transpose_item8(F.w_in, D, NQKV, (unsigned char*)F.WIG, 0, scr, r, F.lane); continue; } r -= I_IN;
        if (r < I_G) { p0_transpose_item8(F.w_gate, D, NGATE, (unsigned char*)F.WIG, NQKV, scr, r, F.lane); continue; } r -= I_G;
        if (r < I_B) { p0_transpose_item(F.w_bsb, HW, D, F.WSB, 0, scr, r, F.lane); continue; } r -= I_B;
        if (r < I_B) { p0_transpose_item(F.w_bmb, HW, D, F.WMB, 0, scr, r, F.lane); continue; } r -= I_B;
        if (r < I_O) { p0_transpose_item8(F.w_out, D, D, (unsigned char*)F.WOUT, 0, scr, r, F.lane); continue; } r -= I_O;
        p0_transpose_item(F.w_pq, D, D, F.WPQ, 0, scr, r, F.lane);
    }
    for (int m = gw; m < M; m += NGW) {
        const GAS f32x4* xr = (const GAS f32x4*)(F.x + (size_t)m * D) + F.lane;
        GAS unsigned* o4 = (GAS unsigned*)((unsigned char*)F.XB + (size_t)m * D) + F.lane;
#pragma unroll
        for (int j = 0; j < 8; ++j) { const f32x4 v = xr[64 * j]; o4[64 * j] = pk4_fp8(v.x, v.y, v.z, v.w); }
    }
}

__device__ __forceinline__ void p2_kmean(Frame& F) {
    const int gw = F.vcu * NWAVES + F.wave, NGW = F.G * NWAVES, lane = F.lane;
    for (int it = gw; it < BATCH * NH * MB_NB * 4; it += NGW) {
        const int q = it & 3, n = (it >> 2) % MB_NB, bh = it / (4 * MB_NB), h = bh % NH, b = bh / NH;
        const GAS v4u* kp = (const GAS v4u*)(F.QKV + ((size_t)(S_KMB * NH + h) * M + b * SEQ + n * MB_BLK + q * 64 + (lane >> 4)) * HD) + (lane & 15);
        float a[8];
#pragma unroll
        for (int i = 0; i < 8; ++i) a[i] = 0.f;
#pragma unroll
        for (int r = 0; r < 16; ++r) { const v4u w = kp[(size_t)r * 4 * (HD / 8)];
            a[0] += bflo(w.x); a[1] += bfhi(w.x); a[2] += bflo(w.y); a[3] += bfhi(w.y); a[4] += bflo(w.z); a[5] += bfhi(w.z); a[6] += bflo(w.w); a[7] += bfhi(w.w); }
#pragma unroll
        for (int i = 0; i < 8; ++i) { a[i] += __shfl_xor(a[i], 16); a[i] += __shfl_xor(a[i], 32); }
        if (lane < 16) { GAS f32x4* o = (GAS f32x4*)(F.KMEAN + (size_t)it * HD + 8 * lane); o[0] = (f32x4){a[0], a[1], a[2], a[3]}; o[1] = (f32x4){a[4], a[5], a[6], a[7]}; }
    }
}

__device__ __forceinline__ int rel_bucket(int rel) {
    if (rel < 16) return rel;
    int b = 16;
    b += rel >= 21; b += rel >= 27; b += rel >= 35; b += rel >= 46; b += rel >= 59; b += rel >= 77; b += rel >= 99; b += rel >= 128;
    b += rel >= 166; b += rel >= 216; b += rel >= 280; b += rel >= 363; b += rel >= 470; b += rel >= 609; b += rel >= 790;
    return b;
}

namespace mb {
typedef short bf16x8 __attribute__((ext_vector_type(8)));
typedef short s16x4 __attribute__((ext_vector_type(4)));
typedef float f32x16 __attribute__((ext_vector_type(16)));
typedef unsigned u32x4 __attribute__((ext_vector_type(4)));
#define MB_KSWZ(row, colB) ((row) * 256 + ((colB) ^ (((row) & 7) << 4)))
__device__ __forceinline__ int v_st(int k, int c) { const int kk = (k & ~0xC) | ((k & 4) << 1) | ((k & 8) >> 1); return ((kk >> 3) * 4 + (c >> 5)) * 512 + ((kk & 7) * 32 + (c & 31)) * 2; }
__device__ __forceinline__ int v_rd_base(int lane) { return ((lane & 3) << 3) | (((lane >> 2) & 3) << 6) | (((lane >> 4) & 1) << 5) | (((lane >> 5) & 1) << 8); }
constexpr int v_rd_off(int d0, int ks, int half) { return d0 * 512 + ks * 4096 + half * 2048; }
__device__ __forceinline__ int crow(int r, int hi) { return (r & 3) + 8 * (r >> 2) + 4 * hi; }
__device__ __forceinline__ unsigned cvtpk(float lo, float hi) { unsigned r; asm volatile("v_cvt_pk_bf16_f32 %0, %1, %2" : "=v"(r) : "v"(lo), "v"(hi)); return r; }
constexpr int EXT = 131584;
constexpr int X_SEL = EXT, X_LISTS = EXT + 1024, X_CNT = EXT + 9216, X_UNITS = EXT + 9344, X_CTR = EXT + 9472, X_LUT = EXT + 9488, X_WS = EXT + 12688, X_END = EXT + 14736;
constexpr int LUTN = 800;
}
static_assert(mb::X_END <= LDS_BYTES, "MoBA LDS map");
constexpr size_t WS_PML = WS_IDS;

__device__ __forceinline__ void p3_moba(Frame& F) {
    using namespace mb;
    LAS unsigned char* const lds = F.lds;
    LAS float* const KM = (LAS float*)lds;
    LAS float* const GT = (LAS float*)(lds + 16384);
    LAS unsigned char* const SEL = lds + X_SEL;
    LAS unsigned char* const LISTS = lds + X_LISTS;
    LAS int* const CNT = (LAS int*)(lds + X_CNT);
    LAS unsigned short* const UNITS = (LAS unsigned short*)(lds + X_UNITS);
    LAS int* const CTR = (LAS int*)(lds + X_CTR);
    LAS float* const LUT = (LAS float*)(lds + X_LUT);
    LAS float* const WS = (LAS float*)(lds + X_WS) + F.wave * 64;
    LAS unsigned char* const Kl = lds + F.wave * 16384;
    LAS unsigned char* const Vl = Kl + 8192;
    const int tid = F.tid, lane = F.lane, wave = F.wave, r32 = lane & 31, hi = lane >> 5;
    float* const PO = F.out + (size_t)blockIdx.x * (256 * 4 * 128);
    float* const PML = (float*)((unsigned char*)F.ctl + WS_PML) + (size_t)blockIdx.x * (256 * 4 * 2);
    constexpr float C2 = ATT_SCALE * LOG2E;
    for (int item = F.vcu; item < BATCH * NH * MB_NB; item += F.G) {
        const int pass = item / (BATCH * NH * MB_NB / 2), ii = item % (BATCH * NH * MB_NB / 2);
        const int grp = ii / MB_NB, cix = ii % MB_NB;
        const int bh = (grp + 8 * pass) % (BATCH * NH), qb = pass ? (MB_NB - 1 - cix) : cix, h = bh % NH, b = bh / NH;
        const int nsel = qb < 3 ? qb : 3;
        const bf16* const Qb = F.QKV + ((size_t)(S_QMB * NH + h) * M + b * SEQ + qb * MB_BLK) * HD;
        const bf16* const Kh = F.QKV + ((size_t)(S_KMB * NH + h) * M + b * SEQ) * HD;
        const bf16* const Vh = F.QKV + ((size_t)(S_VMB * NH + h) * M + b * SEQ) * HD;
        __syncthreads();
        for (int i = tid; i < qb * HD; i += NWAVES * 64) { const float* kq = F.KMEAN + ((size_t)(bh * MB_NB + (i >> 7)) * 4) * HD + (i & 127);
            KM[i] = ((kq[0] + kq[HD]) + (kq[2 * HD] + kq[3 * HD])) * (1.0f / MB_BLK); }
        for (int i = tid; i < LUTN; i += NWAVES * 64) LUT[i] = F.rel_bias[h * 32 + rel_bucket(i)];
        if (tid < 32) CNT[tid] = 0;
        if (tid == 0) CTR[1] = 0;
        __syncthreads();
        if (qb > 0) {
            const int i = tid & 255, nh = tid >> 8; const int jmax = qb - nh * 16;
            float acc[16];
#pragma unroll
            for (int j = 0; j < 16; ++j) acc[j] = 0.f;
            const GAS v4u* qp = (const GAS v4u*)(Qb + (size_t)i * HD);
            for (int dc = 0; dc < 16; ++dc) {
                const v4u qw = qp[dc];
                const float q0 = bflo(qw.x), q1 = bfhi(qw.x), q2 = bflo(qw.y), q3 = bfhi(qw.y), q4 = bflo(qw.z), q5 = bfhi(qw.z), q6 = bflo(qw.w), q7 = bfhi(qw.w);
#pragma unroll
                for (int j = 0; j < 16; ++j) if (j < jmax) { const LAS f32x4* kp = (const LAS f32x4*)(KM + (nh * 16 + j) * HD + dc * 8); const f32x4 a = kp[0], c = kp[1];
                    acc[j] += q0 * a.x + q1 * a.y + q2 * a.z + q3 * a.w + q4 * c.x + q5 * c.y + q6 * c.z + q7 * c.w; }
            }
#pragma unroll
            for (int j = 0; j < 16; ++j) if (j < jmax) GT[i * 33 + nh * 16 + j] = acc[j];
        }
        __syncthreads();
        if (tid < 256) {
            unsigned chosen = 0u;
#pragma unroll
            for (int r = 0; r < 3; ++r) {
                int bi = 255;
                if (r < nsel) { float best = -3.0e38f; bi = 0;
                    for (int n = 0; n < qb; ++n) { const float v = GT[tid * 33 + n]; if (!((chosen >> n) & 1u) && v > best) { best = v; bi = n; } }
                    chosen |= 1u << bi;
                    const int pos = __hip_atomic_fetch_add(CNT + bi, 1, __ATOMIC_RELAXED, __HIP_MEMORY_SCOPE_WORKGROUP);
                    LISTS[bi * 256 + pos] = (unsigned char)tid; }
                SEL[tid * 4 + r] = (unsigned char)bi;
            }
        }
        __syncthreads();
        if (wave == 0) {
            const int nun = (lane < qb) ? ((CNT[lane & 31] + 31) >> 5) : 0; int pre = nun;
#pragma unroll
            for (int o = 1; o < 32; o <<= 1) { const int v = __shfl_up(pre, o); if ((lane & 31) >= o) pre += v; }
            const int tot = __shfl(pre, 31); pre -= nun;
            if (lane < 32) for (int k = 0; k < nun; ++k) UNITS[pre + k] = (unsigned short)(lane | (k << 5));
            if (lane < 8) UNITS[tot + lane] = (unsigned short)(0x8000 | (7 - lane));
            if (lane == 0) CTR[0] = tot + 8; }
        __syncthreads();
        const int NU = CTR[0];
        for (;;) {
            int u = 0; if (lane == 0) u = __hip_atomic_fetch_add(CTR + 1, 1, __ATOMIC_RELAXED, __HIP_MEMORY_SCOPE_WORKGROUP);
            u = __builtin_amdgcn_readfirstlane(u);
            if (u >= NU) break;
            const int code = UNITS[u]; const bool own = (code & 0x8000) != 0;
            const int n = own ? qb : (code & 31), ch = own ? (code & 7) : ((code >> 5) & 7);
            int qi, valid = 1, slot = 3;
            if (own) { qi = ch * 32 + r32; }
            else { const int c = CNT[n]; int e = ch * 32 + r32; if (e >= c) { e = c - 1; valid = 0; } qi = LISTS[n * 256 + e];
                   slot = (SEL[qi * 4] == n) ? 0 : ((SEL[qi * 4 + 1] == n) ? 1 : 2); }
            const int nst = own ? (ch + 1) : 8;
            const bool far = !own && (qb - n >= 5);
            const float cfar = LUT[LUTN - 1] * LOG2E;
            const int rel00 = (qb - n) * MB_BLK + qi - 4 * hi;
            bf16x8 qr[8];
            { const bf16* qrow = Qb + (size_t)qi * HD + hi * 8;
#pragma unroll
              for (int d0 = 0; d0 < 8; ++d0) qr[d0] = *(const GAS bf16x8*)(qrow + d0 * 16); }
            const bf16* const Kt = Kh + (size_t)(n * MB_BLK + (lane >> 4)) * HD + (lane & 15) * 8;
            const bf16* const Vt = Vh + (size_t)(n * MB_BLK + (lane >> 4)) * HD + (lane & 15) * 8;
            v4u sreg[8];
#define MB_LOADT(P_, j) do { _Pragma("unroll") for (int i_ = 0; i_ < 8; ++i_) sreg[i_] = *(const GAS v4u*)((P_) + (size_t)((j) * 32 + 4 * i_) * HD); } while (0)
            MB_LOADT(Kt, 0);
            f32x16 o[4] = {}; float m_reg = -1e30f, l_reg = 0.f;
            const int kw0 = MB_KSWZ(lane >> 4, (lane & 15) * 16);
            const int vb0 = (int)(uintptr_t)Vl + v_rd_base(lane);
            LAS const unsigned char* kb[4];
#pragma unroll
            for (int dd = 0; dd < 4; ++dd) kb[dd] = Kl + MB_KSWZ(r32, (dd * 16 + hi * 8) * 2);
            for (int j = 0; j < nst; ++j) {
#pragma unroll
                for (int i_ = 0; i_ < 8; ++i_) { const int row = (lane >> 4) + 4 * i_; *(LAS v4u*)(Kl + MB_KSWZ(row, (lane & 15) * 16)) = sreg[i_]; }
                asm volatile("s_waitcnt lgkmcnt(0)" ::: "memory");
                __builtin_amdgcn_sched_barrier(0);
                MB_LOADT(Vt, j);
                __builtin_amdgcn_sched_barrier(0);
                f32x16 p = {};
#pragma unroll
                for (int d0 = 0; d0 < 8; ++d0) { const bf16x8 kf = *(const LAS bf16x8*)(kb[d0 & 3] + (d0 >> 2) * 128); p = __builtin_amdgcn_mfma_f32_32x32x16_bf16(kf, qr[d0], p, 0, 0, 0); }
                if (far) {
#pragma unroll
                    for (int r = 0; r < 16; ++r) p[r] = fmaf(p[r], C2, cfar);
                } else {
                    const int relj = rel00 - 32 * j;
                    float bs[16];
#pragma unroll
                    for (int r = 0; r < 16; ++r) { const int rel = relj - ((r & 3) + 8 * (r >> 2)); bs[r] = LUT[rel < 0 ? 0 : (rel > LUTN - 1 ? LUTN - 1 : rel)]; }
                    asm volatile("s_waitcnt lgkmcnt(0)" : "+v"(bs[0]), "+v"(bs[1]), "+v"(bs[2]), "+v"(bs[3]), "+v"(bs[4]), "+v"(bs[5]), "+v"(bs[6]), "+v"(bs[7]),
                                 "+v"(bs[8]), "+v"(bs[9]), "+v"(bs[10]), "+v"(bs[11]), "+v"(bs[12]), "+v"(bs[13]), "+v"(bs[14]), "+v"(bs[15]) :: "memory");
#pragma unroll
                    for (int r = 0; r < 16; ++r) { const int rel = relj - ((r & 3) + 8 * (r >> 2)); const float v = fmaf(p[r], C2, bs[r] * LOG2E); p[r] = (rel >= 0) ? v : -__builtin_inff(); }
                }
                float pmax = fmaxf(fmaxf(fmaxf(fmaxf(p[0], p[1]), fmaxf(p[2], p[3])), fmaxf(fmaxf(p[4], p[5]), fmaxf(p[6], p[7]))),
                                   fmaxf(fmaxf(fmaxf(p[8], p[9]), fmaxf(p[10], p[11])), fmaxf(fmaxf(p[12], p[13]), fmaxf(p[14], p[15]))));
                { auto rr = __builtin_amdgcn_permlane32_swap(__float_as_uint(pmax), __float_as_uint(pmax), false, false); pmax = fmaxf(__uint_as_float(rr[0]), __uint_as_float(rr[1])); }
                float mn, alpha;
                if (__all(pmax - m_reg <= 8.0f)) { mn = m_reg; alpha = 1.f; }
                else { mn = fmaxf(m_reg, pmax); alpha = __builtin_amdgcn_exp2f(m_reg - mn); m_reg = mn; }
#pragma unroll
                for (int r = 0; r < 16; ++r) p[r] = __builtin_amdgcn_exp2f(p[r] - mn);
                float ps = (((p[0] + p[1]) + (p[2] + p[3])) + ((p[4] + p[5]) + (p[6] + p[7]))) + (((p[8] + p[9]) + (p[10] + p[11])) + ((p[12] + p[13]) + (p[14] + p[15])));
                { auto rr = __builtin_amdgcn_permlane32_swap(__float_as_uint(ps), __float_as_uint(ps), false, false); ps = __uint_as_float(rr[0]) + __uint_as_float(rr[1]); }
                l_reg = l_reg * alpha + ps;
                if (__any(alpha < 1.f)) {
                    if (hi == 0) WS[r32] = alpha;
                    asm volatile("s_waitcnt lgkmcnt(0)" ::: "memory");
#pragma unroll
                    for (int r = 0; r < 16; ++r) { const float a = WS[crow(r, hi)];
#pragma unroll
                        for (int d_ = 0; d_ < 4; ++d_) o[d_][r] *= a; }
                }
                bf16x8 pa0, pa1;
#define MB_PK4(P, B_, OUT) do { unsigned a0 = cvtpk(P[B_+0], P[B_+1]), a1 = cvtpk(P[B_+2], P[B_+3]); unsigned b0 = cvtpk(P[B_+4], P[B_+5]), b1 = cvtpk(P[B_+6], P[B_+7]); \
        auto r0 = __builtin_amdgcn_permlane32_swap(a0, b0, false, false); auto r1 = __builtin_amdgcn_permlane32_swap(a1, b1, false, false); \
        u32x4 w = {r0[0], r1[0], r0[1], r1[1]}; OUT = *reinterpret_cast<bf16x8*>(&w); } while (0)
                MB_PK4(p, 0, pa0); MB_PK4(p, 8, pa1);
                __builtin_amdgcn_sched_barrier(0);
#pragma unroll
                for (int i_ = 0; i_ < 8; ++i_) { const int row = (lane >> 4) + 4 * i_; *(LAS v4u*)(Vl + v_st(row, (lane & 15) * 8)) = sreg[i_]; }
                asm volatile("s_waitcnt lgkmcnt(0)" ::: "memory");
                __builtin_amdgcn_sched_barrier(0);
                if (j + 1 < nst) MB_LOADT(Kt, j + 1);
                __builtin_amdgcn_sched_barrier(0);
#define MB_TRRD(dst, off) asm volatile("ds_read_b64_tr_b16 %0, %1 offset:%2" : "=&v"(dst) : "v"(vb0), "i"(off) : "memory")
#define MB_PV(d0) do { s16x4 l0, l1, h0, h1; constexpr int b_ = v_rd_off(d0, 0, 0); \
        MB_TRRD(l0, b_); MB_TRRD(h0, b_ + 2048); MB_TRRD(l1, b_ + 4096); MB_TRRD(h1, b_ + 6144); \
        asm volatile("s_waitcnt lgkmcnt(0)" ::: "memory"); __builtin_amdgcn_sched_barrier(0); \
        o[d0] = __builtin_amdgcn_mfma_f32_32x32x16_bf16(pa0, (bf16x8){l0[0], l0[1], l0[2], l0[3], h0[0], h0[1], h0[2], h0[3]}, o[d0], 0, 0, 0); \
        o[d0] = __builtin_amdgcn_mfma_f32_32x32x16_bf16(pa1, (bf16x8){l1[0], l1[1], l1[2], l1[3], h1[0], h1[1], h1[2], h1[3]}, o[d0], 0, 0, 0); } while (0)
                { s16x4 vl[4][4];
#define MB_TR4(d0) do { constexpr int b_ = v_rd_off(d0, 0, 0); MB_TRRD(vl[d0][0], b_); MB_TRRD(vl[d0][1], b_ + 2048); MB_TRRD(vl[d0][2], b_ + 4096); MB_TRRD(vl[d0][3], b_ + 6144); } while (0)
                  MB_TR4(0); MB_TR4(1); MB_TR4(2); MB_TR4(3);
                  asm volatile("s_waitcnt lgkmcnt(0)" ::: "memory"); __builtin_amdgcn_sched_barrier(0);
#pragma unroll
                  for (int d0 = 0; d0 < 4; ++d0) {
                      o[d0] = __builtin_amdgcn_mfma_f32_32x32x16_bf16(pa0, (bf16x8){vl[d0][0][0], vl[d0][0][1], vl[d0][0][2], vl[d0][0][3], vl[d0][1][0], vl[d0][1][1], vl[d0][1][2], vl[d0][1][3]}, o[d0], 0, 0, 0);
                      o[d0] = __builtin_amdgcn_mfma_f32_32x32x16_bf16(pa1, (bf16x8){vl[d0][2][0], vl[d0][2][1], vl[d0][2][2], vl[d0][2][3], vl[d0][3][0], vl[d0][3][1], vl[d0][3][2], vl[d0][3][3]}, o[d0], 0, 0, 0); }
#undef MB_TR4
                }
            }
            if (hi == 0) ((LAS int*)WS)[32 + r32] = valid ? (qi * 4 + slot) : -1;
            asm volatile("s_waitcnt lgkmcnt(0)" ::: "memory");
#pragma unroll
            for (int r = 0; r < 16; ++r) { const int ri = ((LAS int*)WS)[32 + crow(r, hi)];
                if (ri >= 0) { float* dst = PO + (size_t)ri * 128 + r32;
#pragma unroll
                    for (int d_ = 0; d_ < 4; ++d_) dst[d_ * 32] = o[d_][r]; } }
            if (hi == 0 && valid) { float* ml = PML + (size_t)(qi * 4 + slot) * 2; ml[0] = m_reg; ml[1] = l_reg; }
            asm volatile("s_waitcnt lgkmcnt(0)" ::: "memory");
        }
        asm volatile("s_waitcnt vmcnt(0)" ::: "memory");
        __syncthreads();
        if (tid == 0) { __builtin_amdgcn_fence(__ATOMIC_ACQUIRE, "agent"); asm volatile("s_waitcnt vmcnt(0)" ::: "memory"); }
        __syncthreads();
        {
            const int qs = lane >> 4, dl = lane & 15;
#pragma unroll 2
            for (int it = 0; it < 8; ++it) {
                const int i = wave * 32 + 4 * it + qs;
                f32x2 ml[4]; f32x4 oa[4], ob[4];
#pragma unroll
                for (int s2 = 0; s2 < 4; ++s2) { const bool ok = (s2 == 3) || (s2 < nsel);
                    if (ok) { ml[s2] = *(const GAS f32x2*)(PML + (size_t)(i * 4 + s2) * 2); const GAS f32x4* src = (const GAS f32x4*)(PO + (size_t)(i * 4 + s2) * 128 + 8 * dl); oa[s2] = src[0]; ob[s2] = src[1]; }
                    else { ml[s2] = (f32x2){-3.0e38f, 0.f}; oa[s2] = (f32x4){0.f, 0.f, 0.f, 0.f}; ob[s2] = oa[s2]; } }
                const float mx = fmaxf(fmaxf(ml[0].x, ml[1].x), fmaxf(ml[2].x, ml[3].x));
                float L = 0.f; f32x4 ra = {0.f, 0.f, 0.f, 0.f}, rb = ra;
#pragma unroll
                for (int s2 = 0; s2 < 4; ++s2) { const float w = __builtin_amdgcn_exp2f(ml[s2].x - mx); L += w * ml[s2].y; ra = ra + oa[s2] * w; rb = rb + ob[s2] * w; }
                const float inv = 1.0f / L;
                v4u o; o.x = pk2(ra.x * inv, ra.y * inv); o.y = pk2(ra.z * inv, ra.w * inv); o.z = pk2(rb.x * inv, rb.y * inv); o.w = pk2(rb.z * inv, rb.w * inv);
                *(GAS v4u*)(F.OMB + (size_t)(b * SEQ + qb * MB_BLK + i) * HW + h * HD + 8 * dl) = o;
            }
        }
    }
#undef MB_LOADT
#undef MB_PK4
#undef MB_TRRD
#undef MB_PV
}


__device__ __forceinline__ void p2_sb(Frame& F) {
    using namespace mb;
    const int lane = F.lane, wave = F.wave, r32 = lane & 31, hi = lane >> 5;
    LAS unsigned char* const Kl = F.lds + wave * 16384;
    LAS unsigned char* const Vl = Kl + 8192;
    const int gw = F.vcu * NWAVES + wave, NGW = F.G * NWAVES;
    constexpr float C2 = ATT_SCALE * LOG2E;
    const int vb0 = (int)(uintptr_t)Vl + v_rd_base(lane);
    __syncthreads();
    for (int u = gw; u < BATCH * NH * (SEQ / 32); u += NGW) {
        const int bh = u / (SEQ / 32), qt = u % (SEQ / 32), h = bh % NH, b = bh / NH;
        const bf16* const Qb = F.QKV + ((size_t)(S_QSB * NH + h) * M + b * SEQ + qt * 32) * HD;
        const bf16* const Kt = F.QKV + ((size_t)(S_KSB * NH + h) * M + b * SEQ + (lane >> 4)) * HD + (lane & 15) * 8;
        const bf16* const Vt = F.QKV + ((size_t)(S_VSB * NH + h) * M + b * SEQ + (lane >> 4)) * HD + (lane & 15) * 8;
        bf16x8 qr[8];
        { const bf16* qrow = Qb + (size_t)r32 * HD + hi * 8;
#pragma unroll
          for (int d0 = 0; d0 < 8; ++d0) qr[d0] = *(const GAS bf16x8*)(qrow + d0 * 16); }
        v4u sreg[8];
#define SB_LOADT(P_, j) do { _Pragma("unroll") for (int i_ = 0; i_ < 8; ++i_) sreg[i_] = *(const GAS v4u*)((P_) + (size_t)((j) * 32 + 4 * i_) * HD); } while (0)
        SB_LOADT(Kt, qt);
        f32x16 o[4] = {}; float carry = 1.f;
        LAS const unsigned char* kb[4];
#pragma unroll
        for (int dd = 0; dd < 4; ++dd) kb[dd] = Kl + MB_KSWZ(r32, (dd * 16 + hi * 8) * 2);
        for (int j = qt; j >= 0; --j) {
#pragma unroll
            for (int i_ = 0; i_ < 8; ++i_) { const int row = (lane >> 4) + 4 * i_; *(LAS v4u*)(Kl + MB_KSWZ(row, (lane & 15) * 16)) = sreg[i_]; }
            asm volatile("s_waitcnt lgkmcnt(0)" ::: "memory");
            __builtin_amdgcn_sched_barrier(0);
            SB_LOADT(Vt, j);
            __builtin_amdgcn_sched_barrier(0);
            f32x16 p = {};
#pragma unroll
            for (int d0 = 0; d0 < 8; ++d0) { const bf16x8 kf = *(const LAS bf16x8*)(kb[d0 & 3] + (d0 >> 2) * 128); p = __builtin_amdgcn_mfma_f32_32x32x16_bf16(kf, qr[d0], p, 0, 0, 0); }
            float om[16];
            const bool diag = (j == qt);
#pragma unroll
            for (int r = 0; r < 16; ++r) { const float z = fminf(fmaxf(p[r] * C2, -100.f), 100.f); const float e = __builtin_amdgcn_exp2f(-z); float be = __builtin_amdgcn_rcpf(1.0f + e); float ob = e * be;
                if (diag && crow(r, hi) >= r32) { be = 0.f; ob = 1.f; }
                p[r] = be; om[r] = ob; }
            float gp[4], go[4];
#pragma unroll
            for (int g = 0; g < 4; ++g) gp[g] = (om[4 * g] * om[4 * g + 1]) * (om[4 * g + 2] * om[4 * g + 3]);
#pragma unroll
            for (int g = 0; g < 4; ++g) { auto rr = __builtin_amdgcn_permlane32_swap(__float_as_uint(gp[g]), __float_as_uint(gp[g]), false, false); go[g] = __uint_as_float(hi ? rr[0] : rr[1]); }
            float suf = carry;
#pragma unroll
            for (int g = 3; g >= 0; --g) {
                float e_ = hi ? suf : suf * go[g];
                p[4 * g + 3] *= e_; e_ *= om[4 * g + 3];
                p[4 * g + 2] *= e_; e_ *= om[4 * g + 2];
                p[4 * g + 1] *= e_; e_ *= om[4 * g + 1];
                p[4 * g] *= e_;
                suf *= gp[g] * go[g];
            }
            carry = suf;
            bf16x8 pa0, pa1;
#define SB_PK4(P, B_, OUT) do { unsigned a0 = cvtpk(P[B_+0], P[B_+1]), a1 = cvtpk(P[B_+2], P[B_+3]); unsigned b0 = cvtpk(P[B_+4], P[B_+5]), b1 = cvtpk(P[B_+6], P[B_+7]); \
        auto r0 = __builtin_amdgcn_permlane32_swap(a0, b0, false, false); auto r1 = __builtin_amdgcn_permlane32_swap(a1, b1, false, false); \
        u32x4 w = {r0[0], r1[0], r0[1], r1[1]}; OUT = *reinterpret_cast<bf16x8*>(&w); } while (0)
            SB_PK4(p, 0, pa0); SB_PK4(p, 8, pa1);
            __builtin_amdgcn_sched_barrier(0);
#pragma unroll
            for (int i_ = 0; i_ < 8; ++i_) { const int row = (lane >> 4) + 4 * i_; *(LAS v4u*)(Vl + v_st(row, (lane & 15) * 8)) = sreg[i_]; }
            asm volatile("s_waitcnt lgkmcnt(0)" ::: "memory");
            __builtin_amdgcn_sched_barrier(0);
            const bool more = (j > 0) && !__all(carry < SB_EXIT);
            if (more) SB_LOADT(Kt, j - 1);
            __builtin_amdgcn_sched_barrier(0);
#define SB_TRRD(dst, off) asm volatile("ds_read_b64_tr_b16 %0, %1 offset:%2" : "=&v"(dst) : "v"(vb0), "i"(off) : "memory")
#define SB_PV(d0) do { s16x4 l0, l1, h0, h1; constexpr int b_ = v_rd_off(d0, 0, 0); \
        SB_TRRD(l0, b_); SB_TRRD(h0, b_ + 2048); SB_TRRD(l1, b_ + 4096); SB_TRRD(h1, b_ + 6144); \
        asm volatile("s_waitcnt lgkmcnt(0)" ::: "memory"); __builtin_amdgcn_sched_barrier(0); \
        o[d0] = __builtin_amdgcn_mfma_f32_32x32x16_bf16(pa0, (bf16x8){l0[0], l0[1], l0[2], l0[3], h0[0], h0[1], h0[2], h0[3]}, o[d0], 0, 0, 0); \
        o[d0] = __builtin_amdgcn_mfma_f32_32x32x16_bf16(pa1, (bf16x8){l1[0], l1[1], l1[2], l1[3], h1[0], h1[1], h1[2], h1[3]}, o[d0], 0, 0, 0); } while (0)
            { s16x4 vl[4][4];
#define SB_TR4(d0) do { constexpr int b_ = v_rd_off(d0, 0, 0); SB_TRRD(vl[d0][0], b_); SB_TRRD(vl[d0][1], b_ + 2048); SB_TRRD(vl[d0][2], b_ + 4096); SB_TRRD(vl[d0][3], b_ + 6144); } while (0)
              SB_TR4(0); SB_TR4(1); SB_TR4(2); SB_TR4(3);
              asm volatile("s_waitcnt lgkmcnt(0)" ::: "memory"); __builtin_amdgcn_sched_barrier(0);
#pragma unroll
              for (int d0 = 0; d0 < 4; ++d0) {
                  o[d0] = __builtin_amdgcn_mfma_f32_32x32x16_bf16(pa0, (bf16x8){vl[d0][0][0], vl[d0][0][1], vl[d0][0][2], vl[d0][0][3], vl[d0][1][0], vl[d0][1][1], vl[d0][1][2], vl[d0][1][3]}, o[d0], 0, 0, 0);
                  o[d0] = __builtin_amdgcn_mfma_f32_32x32x16_bf16(pa1, (bf16x8){vl[d0][2][0], vl[d0][2][1], vl[d0][2][2], vl[d0][2][3], vl[d0][3][0], vl[d0][3][1], vl[d0][3][2], vl[d0][3][3]}, o[d0], 0, 0, 0); }
#undef SB_TR4
            }
            if (!more) break;
        }
        bf16* const Ob = F.OSB + (size_t)(b * SEQ + qt * 32) * HW + h * HD;
#pragma unroll
        for (int r = 0; r < 16; ++r) { const int orow = crow(r, hi);
#pragma unroll
            for (int d0 = 0; d0 < 4; ++d0) { const float v = o[d0][r]; const float vn = __shfl_xor(v, 1);
                if ((r32 & 1) == 0) *(GAS unsigned*)(Ob + (size_t)orow * HW + d0 * 32 + r32) = cvtpk(v, vn); } }
    }
#undef SB_LOADT
#undef SB_PK4
#undef SB_TRRD
#undef SB_PV
}

__device__ __forceinline__ void p6_ln1(Frame& F) {
    const int gw = F.vcu * NWAVES + F.wave, NGW = F.G * NWAVES;
    for (int m = gw; m < M; m += NGW) {
        GAS f32x4* xr = (GAS f32x4*)(F.H1 + (size_t)m * D) + F.lane;
        f32x4 v[8]; float s = 0.f;
#pragma unroll
        for (int j = 0; j < 8; ++j) { v[j] = xr[64 * j]; s += (v[j].x + v[j].y) + (v[j].z + v[j].w); }
        const float mean = wave_sum(s) * (1.f / D); float s2 = 0.f;
#pragma unroll
        for (int j = 0; j < 8; ++j) { v[j] = v[j] - mean; s2 += (v[j].x * v[j].x + v[j].y * v[j].y) + (v[j].z * v[j].z + v[j].w * v[j].w); }
        const float rstd = 1.f / sqrtf(wave_sum(s2) * (1.f / D) + LN_EPS);
        GAS v2u* o8 = (GAS v2u*)(F.X1B + (size_t)m * D) + F.lane;
#pragma unroll
        for (int j = 0; j < 8; ++j) { const f32x4 gg = *((const GAS f32x4*)F.ln1_g + F.lane + 64 * j), bb = *((const GAS f32x4*)F.ln1_b + F.lane + 64 * j);
            const f32x4 y = v[j] * rstd * gg + bb; xr[64 * j] = y; v2u w; w.x = pk2(y.x, y.y); w.y = pk2(y.z, y.w); o8[64 * j] = w; }
    }
}

typedef float f32x16v __attribute__((ext_vector_type(16)));
typedef float f32x32v __attribute__((ext_vector_type(32)));
typedef unsigned u32x6v __attribute__((ext_vector_type(6)));
typedef unsigned v4u_a4 __attribute__((ext_vector_type(4), aligned(4)));
typedef unsigned v2u_a4 __attribute__((ext_vector_type(2), aligned(4)));
constexpr float U6_SCALE = 90.f, V6_SCALE = 38.f;
constexpr int ROW6 = D * 6 / 8;
constexpr int ROW4 = D / 2;
__device__ __forceinline__ void p6_tables(Frame& F) {
    const size_t gt = (size_t)F.vcu * (NWAVES * 64) + F.tid, NGT = (size_t)F.G * (NWAVES * 64);
    constexpr size_t NCH = (size_t)PEER_NK * PEER_NK * D / 32;
    for (size_t c = gt; c < 2 * NCH; c += NGT) {
        const bool isv = c >= NCH; const size_t cc = isv ? c - NCH : c;
        const GAS f32x4* src = (const GAS f32x4*)((isv ? F.peer_v : F.peer_u) + cc * 32);
        {
            v4u o;
#pragma unroll
            for (int k = 0; k < 4; ++k) { const f32x4 va = src[2 * k], vb = src[2 * k + 1]; unsigned w = 0u;
                const float sc = isv ? V6_SCALE : U6_SCALE;
                const float e0 = fminf(fmaxf(va[0] * sc, -6.f), 6.f), e1 = fminf(fmaxf(va[1] * sc, -6.f), 6.f), e2 = fminf(fmaxf(va[2] * sc, -6.f), 6.f), e3 = fminf(fmaxf(va[3] * sc, -6.f), 6.f);
                const float e4 = fminf(fmaxf(vb[0] * sc, -6.f), 6.f), e5 = fminf(fmaxf(vb[1] * sc, -6.f), 6.f), e6 = fminf(fmaxf(vb[2] * sc, -6.f), 6.f), e7 = fminf(fmaxf(vb[3] * sc, -6.f), 6.f);
                w = __builtin_amdgcn_cvt_scalef32_pk_fp4_f32(w, e0, e1, 1.0f, 0); w = __builtin_amdgcn_cvt_scalef32_pk_fp4_f32(w, e2, e3, 1.0f, 1);
                w = __builtin_amdgcn_cvt_scalef32_pk_fp4_f32(w, e4, e5, 1.0f, 2); w = __builtin_amdgcn_cvt_scalef32_pk_fp4_f32(w, e6, e7, 1.0f, 3);
                o[k] = w; }
            *(GAS v4u*)((isv ? F.V8 : F.U8) + cc * 16) = o;
        }
    }
}


namespace rt {
typedef short bf16x8 __attribute__((ext_vector_type(8)));
typedef float f32x16 __attribute__((ext_vector_type(16)));
#define RT_KSWZ(row, colB) ((row) * 256 + ((colB) ^ (((row) & 7) << 4)))
constexpr float NEGV = -3.0e38f;
}
__device__ __forceinline__ void sort16_desc(float (&v)[16]) {
#define CE(a, b) do { const float hi_ = fmaxf(a, b), lo_ = fminf(a, b); a = hi_; b = lo_; } while (0)
    CE(v[0], v[1]); CE(v[3], v[2]); CE(v[4], v[5]); CE(v[7], v[6]); CE(v[8], v[9]); CE(v[11], v[10]); CE(v[12], v[13]); CE(v[15], v[14]); CE(v[0], v[2]); CE(v[1], v[3]); CE(v[6], v[4]); CE(v[7], v[5]); CE(v[8], v[10]); CE(v[9], v[11]); CE(v[14], v[12]); CE(v[15], v[13]); CE(v[0], v[1]); CE(v[2], v[3]); CE(v[5], v[4]); CE(v[7], v[6]); CE(v[8], v[9]); CE(v[10], v[11]); CE(v[13], v[12]); CE(v[15], v[14]); CE(v[0], v[4]); CE(v[1], v[5]); CE(v[2], v[6]); CE(v[3], v[7]); CE(v[12], v[8]); CE(v[13], v[9]); CE(v[14], v[10]); CE(v[15], v[11]); CE(v[0], v[2]); CE(v[1], v[3]); CE(v[4], v[6]); CE(v[5], v[7]); CE(v[10], v[8]); CE(v[11], v[9]); CE(v[14], v[12]); CE(v[15], v[13]); CE(v[0], v[1]); CE(v[2], v[3]); CE(v[4], v[5]); CE(v[6], v[7]); CE(v[9], v[8]); CE(v[11], v[10]); CE(v[13], v[12]); CE(v[15], v[14]); CE(v[0], v[8]); CE(v[1], v[9]); CE(v[2], v[10]); CE(v[3], v[11]); CE(v[4], v[12]); CE(v[5], v[13]); CE(v[6], v[14]); CE(v[7], v[15]); CE(v[0], v[4]); CE(v[1], v[5]); CE(v[2], v[6]); CE(v[3], v[7]); CE(v[8], v[12]); CE(v[9], v[13]); CE(v[10], v[14]); CE(v[11], v[15]); CE(v[0], v[2]); CE(v[1], v[3]); CE(v[4], v[6]); CE(v[5], v[7]); CE(v[8], v[10]); CE(v[9], v[11]); CE(v[12], v[14]); CE(v[13], v[15]); CE(v[0], v[1]); CE(v[2], v[3]); CE(v[4], v[5]); CE(v[6], v[7]); CE(v[8], v[9]); CE(v[10], v[11]); CE(v[12], v[13]); CE(v[14], v[15]);
#undef CE
}
__device__ __forceinline__ void merge16_desc(float (&v)[16]) {
#define CE(a, b) do { const float hi_ = fmaxf(a, b), lo_ = fminf(a, b); a = hi_; b = lo_; } while (0)
    CE(v[0], v[8]); CE(v[1], v[9]); CE(v[2], v[10]); CE(v[3], v[11]); CE(v[4], v[12]); CE(v[5], v[13]); CE(v[6], v[14]); CE(v[7], v[15]); CE(v[0], v[4]); CE(v[1], v[5]); CE(v[2], v[6]); CE(v[3], v[7]); CE(v[8], v[12]); CE(v[9], v[13]); CE(v[10], v[14]); CE(v[11], v[15]); CE(v[0], v[2]); CE(v[1], v[3]); CE(v[4], v[6]); CE(v[5], v[7]); CE(v[8], v[10]); CE(v[9], v[11]); CE(v[12], v[14]); CE(v[13], v[15]); CE(v[0], v[1]); CE(v[2], v[3]); CE(v[4], v[5]); CE(v[6], v[7]); CE(v[8], v[9]); CE(v[10], v[11]); CE(v[12], v[13]); CE(v[14], v[15]);
#undef CE
}
__device__ __forceinline__ void p8_route(Frame& F) {
    using namespace rt;
    LAS unsigned char* const lds = F.lds;
    int tid_ = F.tid; asm volatile("" : "+v"(tid_));
    const int tid = tid_, lane = tid_ & 63, wave = F.wave, c32 = lane & 31, hi = lane >> 5;
    LAS unsigned char* const SK = lds;
    LAS float* const TOPS = (LAS float*)(lds + 65536 + wave * 8192);
    LAS int* const IDX = (LAS int*)(lds + 65536 + wave * 8192 + 4096);
    __syncthreads();
    for (int ch = tid; ch < 2 * 128 * 16; ch += NWAVES * 64) {
        const int row = ch >> 4, c = ch & 15; const GAS f32x4* src = (const GAS f32x4*)(F.subkeys + (size_t)row * 128 + c * 8);
        const f32x4 a = src[0], b = src[1]; v4u w; w.x = pk2(a.x, a.y); w.y = pk2(a.z, a.w); w.z = pk2(b.x, b.y); w.w = pk2(b.z, b.w);
        *(LAS v4u*)(SK + (row >> 7) * 32768 + RT_KSWZ(row & 127, c * 16)) = w;
    }
    __syncthreads();
    const int gw = F.vcu * NWAVES + wave, NGW = F.G * NWAVES;
    for (int item = gw; item < (M / 32) * PEER_H; item += NGW) {
        const int h = item % PEER_H, t0 = (item / PEER_H) * 32;
        f32x16 P0[4], P1[4];
#pragma unroll
        for (int p = 0; p < 2; ++p) {
            bf16x8 qf[8];
            { const bf16* qrow = F.QPB + (size_t)(t0 + c32) * D + h * PEER_QD + p * 128 + hi * 8;
#pragma unroll
              for (int d0 = 0; d0 < 8; ++d0) qf[d0] = *(const GAS bf16x8*)(qrow + d0 * 16); }
#pragma unroll
            for (int kg = 0; kg < 4; ++kg) {
                f32x16 acc = {};
#pragma unroll
                for (int d0 = 0; d0 < 8; ++d0) { const bf16x8 kf = *(const LAS bf16x8*)(SK + p * 32768 + RT_KSWZ(kg * 32 + c32, (d0 * 16 + hi * 8) * 2));
                    acc = __builtin_amdgcn_mfma_f32_32x32x16_bf16(kf, qf[d0], acc, 0, 0, 0); }
                if (p == 0) P0[kg] = acc; else P1[kg] = acc;
                __builtin_amdgcn_sched_barrier(0);
            }
        }
        float V[8][16];
#pragma unroll
        for (int kg = 0; kg < 4; ++kg)
#pragma unroll
            for (int r = 0; r < 16; ++r) {
                auto rr = __builtin_amdgcn_permlane32_swap(__float_as_uint(P0[kg][r]), __float_as_uint(P1[kg][r]), false, false);
                const int key0 = kg * 32 + (r & 3) + 8 * (r >> 2);
                V[2 * kg][r] = __uint_as_float((rr[0] & ~0x7Fu) | (unsigned)(127 - key0));
                V[2 * kg + 1][r] = __uint_as_float((rr[1] & ~0x7Fu) | (unsigned)(127 - (key0 + 4)));
            }
#pragma unroll
        for (int g = 0; g < 8; ++g) { sort16_desc(V[g]); __builtin_amdgcn_sched_barrier(0); }
#pragma unroll
        for (int g = 0; g < 8; g += 2) {
#pragma unroll
            for (int i = 0; i < 16; ++i) V[g][i] = fmaxf(V[g][i], V[g + 1][15 - i]);
            merge16_desc(V[g]); __builtin_amdgcn_sched_barrier(0); }
#pragma unroll
        for (int g = 0; g < 8; g += 4) {
#pragma unroll
            for (int i = 0; i < 16; ++i) V[g][i] = fmaxf(V[g][i], V[g + 2][15 - i]);
            merge16_desc(V[g]); __builtin_amdgcn_sched_barrier(0); }
#pragma unroll
        for (int i = 0; i < 16; ++i) V[0][i] = fmaxf(V[0][i], V[4][15 - i]);
        merge16_desc(V[0]);
#pragma unroll
        for (int k = 0; k < 16; ++k) TOPS[lane * 16 + k] = V[0][k];
        asm volatile("s_waitcnt lgkmcnt(0)" ::: "memory");
        float A[16], B[16];
#pragma unroll
        for (int k = 0; k < 16; ++k) { const float mine = TOPS[lane * 16 + k], oth = TOPS[(lane ^ 32) * 16 + k];
            IDX[(c32 * 2 + hi) * 16 + k] = 127 - (int)(__float_as_uint(mine) & 0x7Fu);
            A[k] = hi ? oth : mine; B[k] = hi ? mine : oth; }
        float Cn[4][16];
#pragma unroll
        for (int g = 0; g < 4; ++g)
#pragma unroll
            for (int i = 0; i < 16; ++i) Cn[g][i] = NEGV;
        { int n = 0;
#pragma unroll
          for (int i = 0; i < 16; ++i)
#pragma unroll
              for (int j = 0; j < 16; ++j) if ((i + 1) * (j + 1) <= 16) { Cn[n >> 4][n & 15] = __uint_as_float((__float_as_uint(A[i] + B[j]) & ~0xFFu) | (unsigned)(255 - (16 * i + j))); ++n; } }
#pragma unroll
        for (int g = 0; g < 4; ++g) { sort16_desc(Cn[g]); __builtin_amdgcn_sched_barrier(0); }
#pragma unroll
        for (int g = 0; g < 4; g += 2) {
#pragma unroll
            for (int i = 0; i < 16; ++i) Cn[g][i] = fmaxf(Cn[g][i], Cn[g + 1][15 - i]);
            merge16_desc(Cn[g]); }
#pragma unroll
        for (int i = 0; i < 16; ++i) Cn[0][i] = fmaxf(Cn[0][i], Cn[2][15 - i]);
        merge16_desc(Cn[0]);
        float W[16];
#pragma unroll
        for (int k = 0; k < 16; ++k) W[k] = Cn[0][k];
        asm volatile("s_waitcnt lgkmcnt(0)" ::: "memory");
        if (hi == 0) {
            float den = 0.f, e[16];
#pragma unroll
            for (int k = 0; k < 16; ++k) { e[k] = __builtin_amdgcn_exp2f((W[k] - W[0]) * LOG2E); den += e[k]; }
            const float inv = 1.0f / den;
            int* ido = F.IDS + (size_t)(t0 + c32) * PEER_SEL + h * PEER_K; float* gwo = F.GW + (size_t)(t0 + c32) * PEER_SEL + h * PEER_K;
#pragma unroll
            for (int k4 = 0; k4 < 4; ++k4) { int idv[4]; f32x4 gv;
#pragma unroll
                for (int k = 0; k < 4; ++k) { const int code = 255 - (int)(__float_as_uint(W[4 * k4 + k]) & 0xFFu);
                    idv[k] = IDX[(c32 * 2) * 16 + (code >> 4)] * PEER_NK + IDX[(c32 * 2 + 1) * 16 + (code & 15)]; gv[k] = e[4 * k4 + k] * inv; }
                *(GAS v4u*)(ido + 4 * k4) = (v4u){(unsigned)idv[0], (unsigned)idv[1], (unsigned)idv[2], (unsigned)idv[3]}; *(GAS f32x4*)(gwo + 4 * k4) = gv; }
        }
        asm volatile("s_waitcnt lgkmcnt(0)" ::: "memory");
    }
}

__device__ __forceinline__ f32x32v ld_row6(const unsigned char* tab, int id, int lane) {
    const GAS unsigned char* rp = (const GAS unsigned char*)tab + (size_t)id * ROW6 + 24 * lane;
    const v4u_a4 a = *(const GAS v4u_a4*)rp; const v2u_a4 b = *(const GAS v2u_a4*)(rp + 16);
    const u32x6v w = {a[0], a[1], a[2], a[3], b[0], b[1]};
    return __builtin_amdgcn_cvt_scalef32_pk32_f32_fp6(w, 1.0f);
}
constexpr int P9_GE = 4;
__device__ __forceinline__ float readlane_f(float v, int l) { return __int_as_float(__builtin_amdgcn_readlane(__float_as_int(v), l)); }
typedef int i32x8 __attribute__((ext_vector_type(8)));
__device__ __forceinline__ void p9_gather(Frame& F) {
    LAS unsigned char* const RB = F.lds + F.wave * 16384;
    LAS unsigned char* const XL8 = F.lds + P9X_OFF + F.wave * 2048;
    LAS float* const SC = (LAS float*)(F.lds + MISC_OFF + 192 + F.wave * 512);
    const int gw = F.vcu * NWAVES + F.wave, NGW = F.G * NWAVES, lane = F.lane;
    const int e16 = ((lane >> 5) & 1) * 8 + ((lane >> 4) & 1) * 4 + ((lane >> 3) & 1) * 2 + ((lane >> 2) & 1);
    const int srcl16 = ((lane >> 3) & 1) * 32 + ((lane >> 2) & 1) * 16 + ((lane >> 1) & 1) * 8 + (lane & 1) * 4;
    bool inter;
    { f32x16v t0, t1;
#pragma unroll
      for (int j = 0; j < 16; ++j) { t0[j] = 0.125f * j; t1[j] = j < 8 ? 2.0f + 0.25f * j : 4.0f + 0.5f * (j - 8); }
      const f32x32v y = __builtin_amdgcn_cvt_scalef32_pk32_f32_fp6(__builtin_amdgcn_cvt_scalef32_2xpk16_fp6_f32(t0, t1, 1.0f), 1.0f);
      inter = y[1] != 0.125f; }
    bool swap4;
    { const unsigned w = __builtin_amdgcn_cvt_scalef32_pk_fp4_f32(0u, 1.0f, 2.0f, 1.0f, 0); const f32x2 pr = __builtin_amdgcn_cvt_scalef32_pk_f32_fp4(w, 1.0f, 0); swap4 = pr.x != 1.0f; }
    for (int t = gw; t < M; t += NGW) {
        const int idA = F.IDS[(size_t)t * PEER_SEL + lane], idB = F.IDS[(size_t)t * PEER_SEL + 64 + lane];
        float cfA = 0.f, cfB = 0.f;
        {
            const int q4 = lane >> 4, r16 = lane & 15;
            { const GAS f32x4* xr = (const GAS f32x4*)(F.H1 + (size_t)t * D + 32 * lane); v4u w0, w1;
#pragma unroll
              for (int k = 0; k < 8; ++k) { const f32x4 a = xr[k]; const unsigned pk = pk4_fp8(a[0], a[1], a[2], a[3]); if (k < 4) w0[k] = pk; else w1[k - 4] = pk; }
              *(LAS v4u*)(XL8 + 32 * lane) = w0; *(LAS v4u*)(XL8 + 32 * lane + 16) = w1; }
            const float gwA = F.GW[(size_t)t * PEER_SEL + lane], gwB = F.GW[(size_t)t * PEER_SEL + 64 + lane];
#define P9_LDG(W_, g_) do { const int iv_ = (g_) < 4 ? idA : idB; _Pragma("unroll") for (int e = 0; e < 16; ++e) \
        W_[e] = *((const GAS v4u*)(F.U8 + (size_t)__builtin_amdgcn_readlane(iv_, 16 * ((g_) & 3) + e) * ROW4) + lane); } while (0)
#define P9_GRP(W_, g_) do { _Pragma("unroll") for (int e = 0; e < 16; ++e) *(LAS v4u*)(RB + e * 1024 + 16 * (lane ^ e)) = W_[e]; \
        asm volatile("s_waitcnt lgkmcnt(0)" ::: "memory"); \
        f32x4 acc_ = {0.f, 0.f, 0.f, 0.f}; \
        _Pragma("unroll") for (int c = 0; c < 16; ++c) { const v4u a_ = *(const LAS v4u*)(RB + r16 * 1024 + 16 * ((4 * c + q4) ^ r16)); \
            const v4u b0_ = *(const LAS v4u*)(XL8 + 128 * c + 16 * q4), b1_ = *(const LAS v4u*)(XL8 + 128 * c + 64 + 16 * q4); \
            const i32x8 aa_ = {(int)a_.x, (int)a_.y, (int)a_.z, (int)a_.w, 0, 0, 0, 0}, bb_ = {(int)b0_.x, (int)b0_.y, (int)b0_.z, (int)b0_.w, (int)b1_.x, (int)b1_.y, (int)b1_.z, (int)b1_.w}; \
            acc_ = __builtin_amdgcn_mfma_scale_f32_16x16x128_f8f6f4(aa_, bb_, acc_, 4  , 0  , 0, 0, 0, 0); } \
        if (r16 == 0) *(LAS f32x4*)(SC + 16 * (g_) + 4 * q4) = acc_;        \
        asm volatile("s_waitcnt lgkmcnt(0)" ::: "memory"); } while (0)
            v4u wA[16], wB[16];
            P9_LDG(wA, 0);
#pragma unroll 1
            for (int g = 0; g < 8; g += 2) {
                P9_LDG(wB, g + 1); __builtin_amdgcn_sched_barrier(0);
                P9_GRP(wA, g); __builtin_amdgcn_sched_barrier(0);
                if (g + 2 < 8) P9_LDG(wA, g + 2);
                __builtin_amdgcn_sched_barrier(0);
                P9_GRP(wB, g + 1); __builtin_amdgcn_sched_barrier(0);
            }
#undef P9_LDG
#undef P9_GRP
            { const float a0 = SC[lane] * (1.0f / U6_SCALE), a1 = SC[64 + lane] * (1.0f / U6_SCALE);
              cfA = gwA * (0.5f * a0 * (1.0f + erff(a0 * 0.7071067811865476f))) * (1.0f / V6_SCALE);
              cfB = gwB * (0.5f * a1 * (1.0f + erff(a1 * 0.7071067811865476f))) * (1.0f / V6_SCALE); }
            asm volatile("s_waitcnt lgkmcnt(0)" ::: "memory");
        }
        float os[32];
#pragma unroll
        for (int i = 0; i < 32; ++i) os[i] = 0.f;
        {
#define P9_LDV(W_, g4_) do { const int eb_ = ((g4_) * 4) & 63; const int iv_ = ((g4_) * 4 < 64) ? idA : idB; _Pragma("unroll") for (int e = 0; e < 4; ++e) \
        W_[e] = *((const GAS v4u*)(F.V8 + (size_t)__builtin_amdgcn_readlane(iv_, eb_ + e) * ROW4) + lane); } while (0)
#define P9_ACC(W_, g4_) do { const int eb_ = ((g4_) * 4) & 63; const float cv_ = ((g4_) * 4 < 64) ? cfA : cfB; _Pragma("unroll") for (int e = 0; e < 4; ++e) { const float cf = readlane_f(cv_, eb_ + e); \
        _Pragma("unroll") for (int k = 0; k < 4; ++k) { const unsigned wk = W_[e][k]; \
            const f32x2 p0 = __builtin_amdgcn_cvt_scalef32_pk_f32_fp4(wk, 1.0f, 0), p1 = __builtin_amdgcn_cvt_scalef32_pk_f32_fp4(wk, 1.0f, 1), p2 = __builtin_amdgcn_cvt_scalef32_pk_f32_fp4(wk, 1.0f, 2), p3 = __builtin_amdgcn_cvt_scalef32_pk_f32_fp4(wk, 1.0f, 3); \
            os[8 * k] += cf * p0.x; os[8 * k + 1] += cf * p0.y; os[8 * k + 2] += cf * p1.x; os[8 * k + 3] += cf * p1.y; os[8 * k + 4] += cf * p2.x; os[8 * k + 5] += cf * p2.y; os[8 * k + 6] += cf * p3.x; os[8 * k + 7] += cf * p3.y; } \
        __builtin_amdgcn_sched_barrier(0); } } while (0)
            v4u vA[4], vB[4];
            P9_LDV(vA, 0);
#pragma unroll 1
            for (int g = 0; g < PEER_SEL / 4; g += 2) {
                P9_LDV(vB, g + 1); __builtin_amdgcn_sched_barrier(0);
                P9_ACC(vA, g);
                if (g + 2 < PEER_SEL / 4) P9_LDV(vA, g + 2);
                __builtin_amdgcn_sched_barrier(0);
                P9_ACC(vB, g + 1);
            }
#undef P9_LDV
#undef P9_ACC
        }
        float on[32];
#pragma unroll
        for (int i = 0; i < 16; ++i) { on[2 * i] = swap4 ? os[2 * i + 1] : os[2 * i]; on[2 * i + 1] = swap4 ? os[2 * i] : os[2 * i + 1]; }
        float s = 0.f;
        { const GAS f32x4* xr = (const GAS f32x4*)(F.H1 + (size_t)t * D + 32 * lane);
#pragma unroll
          for (int k = 0; k < 8; ++k) { const f32x4 a = xr[k];
#pragma unroll
              for (int i = 0; i < 4; ++i) { on[4 * k + i] += a[i] * DN_ALPHA; s += on[4 * k + i]; } } }
        const float mean = wave_sum(s) * (1.f / D); float s2 = 0.f;
#pragma unroll
        for (int i = 0; i < 32; ++i) { on[i] -= mean; s2 += on[i] * on[i]; }
        const float rstd = 1.f / sqrtf(wave_sum(s2) * (1.f / D) + LN_EPS);
        GAS f32x4* orow = (GAS f32x4*)(F.out + (size_t)t * D + 32 * lane);
        const GAS f32x4* gr = (const GAS f32x4*)(F.ln2_g + 32 * lane); const GAS f32x4* br = (const GAS f32x4*)(F.ln2_b + 32 * lane);
        asm volatile("" : "+v"(gr), "+v"(br));
#pragma unroll
        for (int k = 0; k < 8; ++k) { const f32x4 g0 = gr[k], b0 = br[k]; f32x4 y0;
#pragma unroll
            for (int i = 0; i < 4; ++i) y0[i] = on[4 * k + i] * rstd * g0[i] + b0[i];
            orow[k] = y0; }
    }
}

struct Args { const float* in[16]; float* out; unsigned char* ws; int ph_lo, ph_hi; };
__global__ void __launch_bounds__(NWAVES * 64, 2) mk_fwd(Args args) {
    extern __shared__ __attribute__((aligned(16))) unsigned char lds[];
    Frame F;
    F.lds = (LAS unsigned char*)lds;
    F.MISC = (volatile LAS unsigned*)(F.lds + MISC_OFF);
    F.tid = threadIdx.x; F.lane = F.tid & 63; F.wave = __builtin_amdgcn_readfirstlane(F.tid >> 6);
    F.G = gridDim.x; { const int bx = blockIdx.x; F.vcu = (F.G % 8 == 0) ? (bx % 8) * (F.G / 8) + bx / 8 : bx; }
    unsigned char* ws = args.ws;
    F.ctl = (gu32*)(ws + WS_CTL);
    F.x = args.in[0]; F.w_in = args.in[1]; F.w_gate = args.in[2]; F.b_gate = args.in[3]; F.w_bsb = args.in[4]; F.w_bmb = args.in[5]; F.w_out = args.in[6]; F.rel_bias = args.in[7];
    F.ln1_g = args.in[8]; F.ln1_b = args.in[9]; F.w_pq = args.in[10]; F.subkeys = args.in[11]; F.peer_u = args.in[12]; F.peer_v = args.in[13]; F.ln2_g = args.in[14]; F.ln2_b = args.in[15];
    F.out = args.out;
    F.KMEAN = (float*)(ws + WS_KMEAN); F.WIG = (bf16*)(ws + WS_WIG); F.WSB = (bf16*)(ws + WS_WSB); F.WMB = (bf16*)(ws + WS_WMB); F.WOUT = (bf16*)(ws + WS_WOUT); F.WPQ = (bf16*)(ws + WS_WPQ);
    F.IDS = (int*)(ws + WS_IDS); F.GW = (float*)(ws + WS_GW);
    F.QKV = (bf16*)(ws + WS_QKV); F.MIXED = (bf16*)(ws + WS_MIXED); F.GATE = (bf16*)(ws + WS_GATE); F.XB = (bf16*)(ws + WS_XB); F.OSB = (bf16*)(ws + WS_OSB); F.OMB = (bf16*)(ws + WS_OMB);
    F.X1B = (bf16*)(ws + WS_X1B); F.H1 = (float*)(ws + WS_H1); F.QP = (float*)(ws + WS_QP); F.QPB = (bf16*)(ws + WS_QP); F.U8 = ws + WS_U8; F.V8 = ws + WS_V8;
    for (int u = F.tid; u < (LDS_BYTES - LDSCTL_OFF) / 4; u += NWAVES * 64) ((LAS unsigned*)(F.lds + LDSCTL_OFF))[u] = 0u;
    __syncthreads();
    XcdBarrier bar; bar.bar = (unsigned*)(F.ctl + CW_BAR); bar.x = 0; bar.st = nullptr;
    if (N_LAUNCHES == 1) bar = xcd_barrier_post((unsigned*)(F.ctl + CW_BAR), F.MISC + 8);
    const int lo = args.ph_lo, hi = args.ph_hi;
#ifndef PHASE_MASK
#define PHASE_MASK 0x3ff
#endif
#define IN(k) (((PHASE_MASK >> (k)) & 1) && lo <= (k) && (k) < hi)
#define SEAM(k) do { if (IN(k) && IN((k) + 1)) xcd_barrier(bar); } while (0)
#ifndef PROBE_DUP
#define PROBE_DUP -1
#endif
#define REP(k) for (int rep_ = 0; rep_ < ((PROBE_DUP == (k)) ? 2 : 1); ++rep_)

    if (IN(0)) REP(0) { p0_prologue(F); SEAM(0); }
    if (IN(1)) REP(1) {
        pg8::Gemm g{F.XB, F.WIG, F.XB, F.WIG, M, N1, D / 2}; pg8::StaticOrder S; S.init(M, N1, F.G, (int)blockIdx.x);
        pg8::EpiQkvGate E{F.QKV, F.GATE, F.b_gate, 1.0f / W8_SCALE};
        pg8::gemm_phase<pg8::EpiQkvGate, pg8::StaticOrder, PG8_ALIGN, PG8_SP2, true>(F.lds + RING_OFF, g, S, E);
        SEAM(1);
    }
    if (IN(2)) REP(2) { p2_kmean(F); p2_sb(F); SEAM(2); }
    if (IN(3)) REP(3) { p3_moba(F); SEAM(3); }
    if (IN(4)) REP(4) {
        pg8::Gemm g{F.OSB, F.WSB, F.OMB, F.WMB, M, D, HW}; pg8::DualOrder S; S.init(M, D, F.G, (int)blockIdx.x);
        pg8::EpiBranch E{F.GATE, F.MIXED};
        pg8::gemm_phase<pg8::EpiBranch, pg8::DualOrder, PG8_ALIGN, PG8_SP2>(F.lds + RING_OFF, g, S, E);
        SEAM(4);
    }
    if (IN(5)) REP(5) {
        pg8::Gemm g{F.MIXED, F.WOUT, F.MIXED, F.WOUT, M, D, D / 2}; pg8::StaticOrder S; S.init(M, D, F.G, (int)blockIdx.x);
        pg8::EpiF32 E{F.H1, F.x, DN_ALPHA, D, 1.0f / W8_SCALE};
        pg8::gemm_phase<pg8::EpiF32, pg8::StaticOrder, PG8_ALIGN, PG8_SP2, true>(F.lds + RING_OFF, g, S, E);
        SEAM(5);
    }
    if (IN(6)) REP(6) { p6_ln1(F); p6_tables(F); SEAM(6); }
    if (IN(7)) REP(7) {
        pg8::Gemm g{F.X1B, F.WPQ, F.X1B, F.WPQ, M, D, D}; pg8::StaticOrder S; S.init(M, D, F.G, (int)blockIdx.x);
        pg8::EpiBf16 E{F.QPB, D};
        pg8::gemm_phase<pg8::EpiBf16, pg8::StaticOrder, PG8_ALIGN, PG8_SP2>(F.lds + RING_OFF, g, S, E);
        SEAM(7);
    }
    if (IN(8)) REP(8) { p8_route(F); SEAM(8); }
    if (IN(9)) REP(9) { p9_gather(F); }
#undef IN
#undef SEAM
}

extern "C" void kernel_launch(void* const* d_in, const int* in_sizes, int n_in, void* d_out, int out_size, void* d_ws, size_t ws_size, hipStream_t stream) {
    static int grid = 0;
    if (grid == 0) {
        if (n_in != 16 || in_sizes[0] != M * D || out_size != M * D || ws_size < WS_END) { fprintf(stderr, "kernel_launch: built for 16 inputs, x/out of %d floats, >= %zu bytes of workspace; got n_in %d, in0 %d, out %d, ws %zu; nothing launched\n", M * D, (size_t)WS_END, n_in, n_in > 0 ? in_sizes[0] : -1, out_size, ws_size); grid = -1; return; }
        int dev = 0, cus = 0, per_cu = 0;
        if (hipGetDevice(&dev) != hipSuccess || hipDeviceGetAttribute(&cus, hipDeviceAttributeMultiprocessorCount, dev) != hipSuccess) { fprintf(stderr, "kernel_launch: hipGetDevice / hipDeviceGetAttribute failed\n"); grid = -1; return; }
        if (hipFuncSetAttribute((const void*)mk_fwd, hipFuncAttributeMaxDynamicSharedMemorySize, LDS_BYTES) != hipSuccess) { fprintf(stderr, "kernel_launch: hipFuncSetAttribute failed\n"); grid = -1; return; }
        if (hipOccupancyMaxActiveBlocksPerMultiprocessor(&per_cu, (const void*)mk_fwd, NWAVES * 64, LDS_BYTES) != hipSuccess || per_cu < 1)
            fprintf(stderr, "kernel_launch: note: occupancy query reports %d workgroups per CU\n", per_cu);
        (void)hipGetLastError();
        grid = cus;
    }
    if (grid < 0) return;
    if (hipMemsetAsync((char*)d_ws + WS_CTL, 0, CTL_ZERO_BYTES, stream) != hipSuccess) { fprintf(stderr, "kernel_launch: hipMemsetAsync failed\n"); return; }
    Args a{};
    for (int i = 0; i < 16; ++i) a.in[i] = (const float*)d_in[i];
    a.out = (float*)d_out; a.ws = (unsigned char*)d_ws;
    for (int li = 0; li < N_LAUNCHES; ++li) {
        a.ph_lo = (N_LAUNCHES == 1) ? 0 : li; a.ph_hi = (N_LAUNCHES == 1) ? N_PHASES : li + 1;
        hipLaunchKernelGGL(mk_fwd, dim3(grid), dim3(NWAVES * 64), LDS_BYTES, stream, a);
        const hipError_t le = hipPeekAtLastError();
        if (le != hipSuccess) { fprintf(stderr, "kernel_launch: launch %d failed: %s\n", li, hipGetErrorName(le)); break; }
    }
#ifdef PROBE_PHASE
    a.ph_lo = PROBE_PHASE; a.ph_hi = PROBE_PHASE + 1;
    hipLaunchKernelGGL(mk_fwd, dim3(grid), dim3(NWAVES * 64), LDS_BYTES, stream, a);
#endif
}
```

```cpp
#include <hip/hip_runtime.h>
#include <cstdio>
#include <cstdint>
#include <cmath>
namespace pg8 {
#define PG8_LAS __attribute__((address_space(3)))
typedef unsigned short bf16_t;
typedef short bf16x8 __attribute__((ext_vector_type(8)));
typedef float f32x4 __attribute__((ext_vector_type(4)));
typedef unsigned u32x4 __attribute__((ext_vector_type(4)));
constexpr int BM = 256, BK = 64, HALF = 128, HTB = HALF * BK * 2  , STAGE_BYTES = 8 * HTB, NXCD = 8, WGM = 4;

__host__ __device__ __forceinline__ int lds_byte(int r, int c) { const int st = (r >> 4) * 2 + (c >> 5), rr = r & 15, cc = c & 31, ob = rr * 64 + cc * 2; return st * 1024 + (ob ^ (((ob >> 9) & 1) << 5)); }
__host__ __device__ __forceinline__ void stage_rc(int b, int& R, int& C) { const int st = b / 1024, sb = b % 1024, swz = sb ^ (((sb >> 9) & 1) << 5); R = (st >> 1) * 16 + swz / 64; C = (st & 1) * 32 + (swz % 64) / 2; }
__host__ __device__ __forceinline__ int perm32(int rho) { const int n = rho >> 4, i = rho & 15; return 8 * (i >> 2) + 4 * n + (i & 3); }

struct Unit { int pm, pn, src; };
struct Gemm { const bf16_t* A; const bf16_t* Bt; const bf16_t* A1; const bf16_t* Bt1; int M, N, K; };

struct StaticOrder {
    int nM, nN, nwg, G, c;
    __host__ __device__ void init(int M, int N, int G_, int c_) { nM = M / BM; nN = N / BM; nwg = nM * nN; G = G_; c = c_; }
    __host__ __device__ bool next(int i, Unit& u) const {
        const long L = (long)i * G + c; if (L >= nwg) return false;
        int wgid = (int)L; { const int q = nwg / NXCD, r = nwg % NXCD, xcd = wgid % NXCD, off = wgid / NXCD; wgid = (xcd < r ? xcd * (q + 1) : r * (q + 1) + (xcd - r) * q) + off; }
        const int nig = WGM * nN, gid = wgid / nig, fm = gid * WGM, gsz = (nM - fm) < WGM ? (nM - fm) : WGM;
        u.pm = fm + ((wgid % nig) % gsz); u.pn = (wgid % nig) / gsz; u.src = 0; return true;
    }
    __device__ __forceinline__ void a_ready(const Unit&) const {}
    __device__ __forceinline__ void done(const Unit&) const {}
};

__device__ __forceinline__ unsigned cvt_pk_bf16(float lo, float hi) { unsigned r; asm volatile("v_cvt_pk_bf16_f32 %0, %1, %2" : "=v"(r) : "v"(lo), "v"(hi)); return r; }
typedef float f32x2 __attribute__((ext_vector_type(2)));
__device__ __forceinline__ f32x2 gelu_pk(f32x2 v) {
    const f32x2 av = __builtin_elementwise_abs(v), d = av * 0.2316418882f + 1.0f;
    f32x2 t; t.x = __builtin_amdgcn_rcpf(d.x); t.y = __builtin_amdgcn_rcpf(d.y);
    f32x2 q = t * 0.5307027145f + (-0.7265760135f); q = q * t + 0.7107068705f; q = q * t + (-0.142248368f); q = q * t + 0.127414796f; q = q * t;
    const f32x2 s = (v * v) * (-0.72134752044f);
    f32x2 e; e.x = __builtin_amdgcn_exp2f(s.x); e.y = __builtin_amdgcn_exp2f(s.y);
    const f32x2 m = v * (q * e), r = v - m;
    f32x2 o; o.x = v.x < 0.f ? m.x : r.x; o.y = v.y < 0.f ? m.y : r.y; return o;
}

__device__ __forceinline__ float bf2f(unsigned short b) { return __uint_as_float((unsigned)b << 16); }
__device__ __forceinline__ float bflo(unsigned w) { return __uint_as_float(w << 16); }
__device__ __forceinline__ float bfhi(unsigned w) { return __uint_as_float(w & 0xffff0000u); }
__device__ __forceinline__ float sigmoid_fast(float v) { return __builtin_amdgcn_rcpf(1.0f + __builtin_amdgcn_exp2f(-1.4426950408889634f * v)); }

struct EpiQkvGate {
    static constexpr bool PERM = true, AFTER_DRAIN = false;
    bf16_t* QKV; bf16_t* GATE; const float* bgate; float oscale;
    __device__ __forceinline__ bool keep(const Unit&) const { return false; }
    __device__ __forceinline__ void operator()(f32x4 (&acc)[2][2][4][2], const Unit& u, int wr, int wc, int fr, int fq) const {
        const int row0 = u.pm * BM + wr * 64 + fr; const int colt = u.pn * BM;
        const bool isgate = colt >= 6144;
        bf16_t* base = isgate ? GATE : QKV + (size_t)(colt >> 7) * 16384 * 128; const int ldc = isgate ? 4096 : 128; const int cb = isgate ? colt - 6144 : 0;
        const size_t hstep = isgate ? (size_t)HALF : (size_t)16384 * 128;
        const int col0 = cb + wc * 32 + 8 * fq;
        f32x4 bv[2][2];
#pragma unroll
        for (int bj = 0; bj < 2; ++bj)
#pragma unroll
            for (int n = 0; n < 2; ++n) bv[bj][n] = isgate ? *(const f32x4*)(bgate + col0 + bj * HALF + 4 * n) : (f32x4){0.f, 0.f, 0.f, 0.f};
#pragma unroll
        for (int ai = 0; ai < 2; ++ai)
#pragma unroll
            for (int m = 0; m < 4; ++m) { bf16_t* rowp = base + (size_t)(row0 + ai * HALF + m * 16) * ldc + col0;
#pragma unroll
                for (int bj = 0; bj < 2; ++bj) { f32x4 v0 = acc[ai][bj][m][0] * oscale + bv[bj][0], v1 = acc[ai][bj][m][1] * oscale + bv[bj][1];
                    if (isgate) {
#pragma unroll
                        for (int i = 0; i < 4; ++i) { v0[i] = sigmoid_fast(v0[i]); v1[i] = sigmoid_fast(v1[i]); } }
                    u32x4 w; w.x = cvt_pk_bf16(v0[0], v0[1]); w.y = cvt_pk_bf16(v0[2], v0[3]); w.z = cvt_pk_bf16(v1[0], v1[1]); w.w = cvt_pk_bf16(v1[2], v1[3]);
                    *(u32x4*)(rowp + bj * hstep) = w; } }
    }
};

struct EpiBranch {
    static constexpr bool PERM = true, AFTER_DRAIN = false;
    const bf16_t* GATE; bf16_t* MIXED;
    __device__ __forceinline__ bool keep(const Unit& u) const { return u.src == 0; }
    __device__ __forceinline__ void operator()(f32x4 (&acc)[2][2][4][2], const Unit& u, int wr, int wc, int fr, int fq) const {
        const int row0 = u.pm * BM + wr * 64 + fr; const int col0 = u.pn * BM + wc * 32 + 8 * fq;
#pragma unroll
        for (int ai = 0; ai < 2; ++ai)
#pragma unroll
            for (int m = 0; m < 4; ++m) { const size_t r = (size_t)(row0 + ai * HALF + m * 16);
#pragma unroll
                for (int bj = 0; bj < 2; ++bj) {
                    const u32x4 gm = *(const u32x4*)(GATE + r * 4096 + 2048 + col0 + bj * HALF);
                    float m_[8] = {bflo(gm.x), bfhi(gm.x), bflo(gm.y), bfhi(gm.y), bflo(gm.z), bfhi(gm.z), bflo(gm.w), bfhi(gm.w)};
#pragma unroll
                    for (int i = 0; i < 8; ++i) m_[i] = fmaxf(m_[i], 1e-30f);
                    if (u.src == 0) {
                        const u32x4 gs = *(const u32x4*)(GATE + r * 4096 + col0 + bj * HALF);
                        const float s_[8] = {bflo(gs.x), bfhi(gs.x), bflo(gs.y), bfhi(gs.y), bflo(gs.z), bfhi(gs.z), bflo(gs.w), bfhi(gs.w)};
#pragma unroll
                        for (int i = 0; i < 4; ++i) { acc[ai][bj][m][0][i] *= s_[i] * __builtin_amdgcn_rcpf(m_[i]); acc[ai][bj][m][1][i] *= s_[4 + i] * __builtin_amdgcn_rcpf(m_[4 + i]); }
                    } else {
                        f32x4 v0 = acc[ai][bj][m][0], v1 = acc[ai][bj][m][1];
#pragma unroll
                        for (int i = 0; i < 4; ++i) { v0[i] *= m_[i]; v1[i] *= m_[4 + i]; }
                        int w0 = 0, w1 = 0;
                        w0 = __builtin_amdgcn_cvt_pk_fp8_f32(fminf(fmaxf(v0[0], -448.f), 448.f), fminf(fmaxf(v0[1], -448.f), 448.f), w0, false); w0 = __builtin_amdgcn_cvt_pk_fp8_f32(fminf(fmaxf(v0[2], -448.f), 448.f), fminf(fmaxf(v0[3], -448.f), 448.f), w0, true);
                        w1 = __builtin_amdgcn_cvt_pk_fp8_f32(fminf(fmaxf(v1[0], -448.f), 448.f), fminf(fmaxf(v1[1], -448.f), 448.f), w1, false); w1 = __builtin_amdgcn_cvt_pk_fp8_f32(fminf(fmaxf(v1[2], -448.f), 448.f), fminf(fmaxf(v1[3], -448.f), 448.f), w1, true);
                        typedef unsigned pg8_u32x2 __attribute__((ext_vector_type(2)));
                        *(pg8_u32x2*)((unsigned char*)MIXED + r * 2048 + col0 + bj * HALF) = (pg8_u32x2){(unsigned)w0, (unsigned)w1}; } } }
    }
};

struct EpiF32 {
    static constexpr bool PERM = false, AFTER_DRAIN = false;
    float* out; const float* res; float alpha; int ldc; float oscale;
    __device__ __forceinline__ bool keep(const Unit&) const { return false; }
    __device__ __forceinline__ void operator()(f32x4 (&acc)[2][2][4][2], const Unit& u, int wr, int wc, int fr, int fq) const {
        const int row0 = u.pm * BM + wr * 64 + fr; const int col0 = u.pn * BM + wc * 32 + 4 * fq;
#pragma unroll
        for (int ai = 0; ai < 2; ++ai)
#pragma unroll
            for (int m = 0; m < 4; ++m) { const size_t off = (size_t)(row0 + ai * HALF + m * 16) * ldc + col0;
#pragma unroll
                for (int bj = 0; bj < 2; ++bj)
#pragma unroll
                    for (int n = 0; n < 2; ++n) { f32x4 v = acc[ai][bj][m][n] * oscale;
                        if (res) { const f32x4 x = *(const f32x4*)(res + off + bj * HALF + n * 16); v = v + x * alpha; }
                        *(f32x4*)(out + off + bj * HALF + n * 16) = v; } }
    }
};

struct EpiBf16 {
    static constexpr bool PERM = true, AFTER_DRAIN = false;
    bf16_t* O; int ldc;
    __device__ __forceinline__ bool keep(const Unit&) const { return false; }
    __device__ __forceinline__ void operator()(f32x4 (&acc)[2][2][4][2], const Unit& u, int wr, int wc, int fr, int fq) const {
        const int row0 = u.pm * BM + wr * 64 + fr; const int col0 = u.pn * BM + wc * 32 + 8 * fq;
#pragma unroll
        for (int ai = 0; ai < 2; ++ai)
#pragma unroll
            for (int m = 0; m < 4; ++m) { bf16_t* rowp = O + (size_t)(row0 + ai * HALF + m * 16) * ldc + col0;
#pragma unroll
                for (int bj = 0; bj < 2; ++bj) { const f32x4 v0 = acc[ai][bj][m][0], v1 = acc[ai][bj][m][1];
                    u32x4 w; w.x = cvt_pk_bf16(v0[0], v0[1]); w.y = cvt_pk_bf16(v0[2], v0[3]); w.z = cvt_pk_bf16(v1[0], v1[1]); w.w = cvt_pk_bf16(v1[2], v1[3]);
                    *(u32x4*)(rowp + bj * HALF) = w; } }
    }
};

struct DualOrder {
    StaticOrder so;
    __host__ __device__ void init(int M, int N, int G_, int c_) { so.init(M, N, G_, c_); }
    __host__ __device__ bool next(int i, Unit& u) const { if (!so.next(i >> 1, u)) return false; u.src = i & 1; return true; }
    __device__ __forceinline__ void a_ready(const Unit&) const {}
    __device__ __forceinline__ void done(const Unit&) const {}
};


typedef int pg8_i32x4 __attribute__((ext_vector_type(4)));
typedef int pg8_i32x8 __attribute__((ext_vector_type(8)));
template <class Epi, class Sched, bool ALIGN_EPI = false, bool SP2 = false, bool F8 = false>
__device__ __forceinline__ void gemm_phase(PG8_LAS unsigned char* lds, const Gemm g, const Sched& S, const Epi& E) {
    int tid_ = threadIdx.x; asm volatile("" : "+v"(tid_));
    const int tid = tid_, wid = __builtin_amdgcn_readfirstlane(tid >> 6), lane = tid & 63, wr = wid >> 2, wc = wid & 3, fr = lane & 15, fq = lane >> 4;
    const int K = g.K, nt = K / BK;
    unsigned voffA[2], voffB[2];
#pragma unroll
    for (int i = 0; i < 2; ++i) { int R, C; stage_rc(tid * 16 + i * 8192, R, C); const int Rb = Epi::PERM ? ((R & ~31) + perm32(R & 31)) : R;
        voffA[i] = (unsigned)(R * K + C) * 2u; voffB[i] = (unsigned)(Rb * K + C) * 2u; }
    const size_t kstep = (size_t)(BK * 2);
    const size_t hstep = (size_t)HALF * K * 2;
    const size_t tstep = 2 * hstep;
    const unsigned ldsw = (unsigned)wid * 1024u;
    const int aoff = lds_byte(wr * 64 + fr, fq * 8), boff = lds_byte(wc * 32 + fr, fq * 8);
#define PG8_SA(b, h) (((b) * 2 + (h)) * HTB)
#define PG8_SB(b, h) ((4 + (b) * 2 + (h)) * HTB)
#define PG8_STAGE(bufoff, gbase, voff) do { _Pragma("unroll") for (int _i = 0; _i < 2; ++_i) { unsigned vo_ = (voff)[_i]; asm volatile("" : "+v"(vo_));     \
        __builtin_amdgcn_global_load_lds((const unsigned*)((const char*)(gbase) + vo_), (PG8_LAS unsigned*)(lds + (bufoff) + ldsw + _i * 8192), 16, 0, 0); } } while (0)
#define PG8_LD8(dst8, addr) do { const pg8_i32x4 lo_ = *(const PG8_LAS pg8_i32x4*)(addr), hi_ = *(const PG8_LAS pg8_i32x4*)((addr) + 1024); dst8 = (pg8_i32x8){lo_.x, lo_.y, lo_.z, lo_.w, hi_.x, hi_.y, hi_.z, hi_.w}; } while (0)
#define PG8_LDA(dst, b, h) do { if constexpr (F8) { _Pragma("unroll") for (int m = 0; m < 4; ++m) PG8_LD8(dst##8[m], lds + PG8_SA(b, h) + aoff + m * 2048); } \
        else { _Pragma("unroll") for (int m = 0; m < 4; ++m) _Pragma("unroll") for (int k = 0; k < 2; ++k) dst[m][k] = *(const PG8_LAS bf16x8*)(lds + PG8_SA(b, h) + aoff + m * 2048 + k * 1024); } } while (0)
#define PG8_LDB(dst, b, h) do { if constexpr (F8) { _Pragma("unroll") for (int n = 0; n < 2; ++n) PG8_LD8(dst##8[n], lds + PG8_SB(b, h) + boff + n * 2048); } \
        else { _Pragma("unroll") for (int n = 0; n < 2; ++n) _Pragma("unroll") for (int k = 0; k < 2; ++k) dst[n][k] = *(const PG8_LAS bf16x8*)(lds + PG8_SB(b, h) + boff + n * 2048 + k * 1024); } } while (0)
#define PG8_MMA(ai, bj, At, Bt) do { __builtin_amdgcn_s_setprio(1); _Pragma("unroll") for (int m = 0; m < 4; ++m) _Pragma("unroll") for (int n = 0; n < 2; ++n) { \
        if constexpr (F8) acc[ai][bj][m][n] = __builtin_amdgcn_mfma_scale_f32_16x16x128_f8f6f4(Bt##8[n], At##8[m], acc[ai][bj][m][n], 0, 0, 0, 0, 0, 0); \
        else { _Pragma("unroll") for (int k = 0; k < 2; ++k) acc[ai][bj][m][n] = __builtin_amdgcn_mfma_f32_16x16x32_bf16(Bt[n][k], At[m][k], acc[ai][bj][m][n], 0, 0, 0); } } \
        __builtin_amdgcn_s_setprio(0); } while (0)
#define PG8_WAIT_V(n) asm volatile("s_waitcnt vmcnt(" #n ")" ::: "memory")
#define PG8_WAIT_L(n) asm volatile("s_waitcnt lgkmcnt(" #n ")" ::: "memory")
#define PG8_BAR __builtin_amdgcn_s_barrier()
#define PG8_SCHED __builtin_amdgcn_sched_barrier(0)
    Unit cur, nxt; int ui = 0;
    if (!S.next(0, cur)) return;
    f32x4 acc[2][2][4][2];
#pragma unroll
    for (int a = 0; a < 2; ++a)
#pragma unroll
        for (int b = 0; b < 2; ++b)
#pragma unroll
            for (int m = 0; m < 4; ++m)
#pragma unroll
                for (int n = 0; n < 2; ++n) acc[a][b][m][n] = (f32x4){0.f, 0.f, 0.f, 0.f};
    bf16x8 At[4][2], B0[2][2], B1[2][2]; pg8_i32x8 At8[4], B08[2], B18[2];
    const char* cA = (const char*)(cur.src ? g.A1 : g.A) + (size_t)cur.pm * tstep; const char* cB = (const char*)(cur.src ? g.Bt1 : g.Bt) + (size_t)cur.pn * tstep;
    S.a_ready(cur);
    if constexpr (SP2) {
        PG8_STAGE(PG8_SB(0, 0), cB, voffB); PG8_STAGE(PG8_SB(0, 1), cB + hstep, voffB); PG8_STAGE(PG8_SA(0, 0), cA, voffA); PG8_STAGE(PG8_SA(0, 1), cA + hstep, voffA);
        if (wr == 1) PG8_BAR;
        PG8_WAIT_V(2); PG8_BAR;
        PG8_STAGE(PG8_SB(1, 0), cB + kstep, voffB); PG8_STAGE(PG8_SA(1, 0), cA + kstep, voffA); PG8_STAGE(PG8_SB(1, 1), cB + hstep + kstep, voffB);
        PG8_WAIT_V(6); PG8_BAR;
    } else {
        PG8_STAGE(PG8_SB(0, 0), cB, voffB); PG8_STAGE(PG8_SA(0, 0), cA, voffA); PG8_STAGE(PG8_SB(0, 1), cB + hstep, voffB); PG8_STAGE(PG8_SA(0, 1), cA + hstep, voffA);
        if (wr == 1) PG8_BAR;
        PG8_WAIT_V(4); PG8_BAR;
        PG8_STAGE(PG8_SB(1, 0), cB + kstep, voffB); PG8_STAGE(PG8_SA(1, 0), cA + kstep, voffA); PG8_STAGE(PG8_SB(1, 1), cB + hstep + kstep, voffB);
        PG8_WAIT_V(6); PG8_BAR;
    }
    for (;;) {
        const bool has_next = S.next(ui + 1, nxt);
        const char* nA = has_next ? (const char*)(nxt.src ? g.A1 : g.A) + (size_t)nxt.pm * tstep : cA; const char* nB = has_next ? (const char*)(nxt.src ? g.Bt1 : g.Bt) + (size_t)nxt.pn * tstep : cB;
        for (int t = 0; t < nt; t += 2) {
            const bool last = (t == nt - 2);
            const char* a1 = cA + (size_t)(t + 1) * kstep;
            const char* a2 = last ? nA : cA + (size_t)(t + 2) * kstep; const char* b2 = last ? nB : cB + (size_t)(t + 2) * kstep;
            const char* a3 = a2 + kstep; const char* b3 = b2 + kstep;
            if (last && has_next) S.a_ready(nxt);
            if constexpr (SP2) {
            PG8_LDB(B0, 0, 0); PG8_LDB(B1, 0, 1); PG8_SCHED; PG8_LDA(At, 0, 0); PG8_STAGE(PG8_SA(1, 1), a1 + hstep, voffA);
            PG8_WAIT_V(8); PG8_WAIT_L(0); PG8_BAR; PG8_MMA(0, 0, At, B0); PG8_MMA(0, 1, At, B1); PG8_BAR; PG8_SCHED;
            PG8_LDA(At, 0, 1); PG8_STAGE(PG8_SB(0, 0), b2, voffB); PG8_STAGE(PG8_SB(0, 1), b2 + hstep, voffB); PG8_STAGE(PG8_SA(0, 0), a2, voffA);
            PG8_WAIT_V(8); PG8_WAIT_L(0); PG8_BAR; PG8_MMA(1, 0, At, B0); PG8_MMA(1, 1, At, B1); PG8_BAR; PG8_SCHED;
            PG8_LDB(B0, 1, 0); PG8_LDB(B1, 1, 1); PG8_SCHED; PG8_LDA(At, 1, 0); PG8_STAGE(PG8_SA(0, 1), a2 + hstep, voffA);
            PG8_WAIT_V(8); PG8_WAIT_L(0); PG8_BAR; PG8_MMA(0, 0, At, B0); PG8_MMA(0, 1, At, B1); PG8_BAR; PG8_SCHED;
            PG8_LDA(At, 1, 1); PG8_STAGE(PG8_SB(1, 0), b3, voffB); PG8_STAGE(PG8_SB(1, 1), b3 + hstep, voffB); PG8_STAGE(PG8_SA(1, 0), a3, voffA);
            PG8_WAIT_V(8); PG8_WAIT_L(0); PG8_BAR; PG8_MMA(1, 0, At, B0); PG8_MMA(1, 1, At, B1); PG8_BAR; PG8_SCHED;
            } else {
            PG8_LDB(B0, 0, 0); PG8_SCHED; PG8_LDA(At, 0, 0); PG8_STAGE(PG8_SA(1, 1), a1 + hstep, voffA);
            PG8_WAIT_L(8); PG8_BAR; PG8_WAIT_L(0); PG8_MMA(0, 0, At, B0); PG8_BAR; PG8_SCHED;
            PG8_LDB(B1, 0, 1); PG8_STAGE(PG8_SB(0, 0), b2, voffB);
            PG8_BAR; PG8_WAIT_L(0); PG8_MMA(0, 1, At, B1); PG8_BAR;
            PG8_LDA(At, 0, 1); PG8_STAGE(PG8_SA(0, 0), a2, voffA);
            PG8_BAR; PG8_WAIT_L(0); PG8_MMA(1, 0, At, B0); PG8_BAR; PG8_SCHED;
            PG8_STAGE(PG8_SB(0, 1), b2 + hstep, voffB);
            PG8_WAIT_V(6); PG8_BAR; PG8_MMA(1, 1, At, B1); PG8_BAR;
            PG8_LDB(B0, 1, 0); PG8_SCHED; PG8_LDA(At, 1, 0); PG8_STAGE(PG8_SA(0, 1), a2 + hstep, voffA);
            PG8_WAIT_L(8); PG8_BAR; PG8_WAIT_L(0); PG8_MMA(0, 0, At, B0); PG8_BAR; PG8_SCHED;
            PG8_LDB(B1, 1, 1); PG8_STAGE(PG8_SB(1, 0), b3, voffB);
            PG8_BAR; PG8_WAIT_L(0); PG8_MMA(0, 1, At, B1); PG8_BAR;
            PG8_LDA(At, 1, 1); PG8_STAGE(PG8_SA(1, 0), a3, voffA);
            PG8_BAR; PG8_WAIT_L(0); PG8_MMA(1, 0, At, B0); PG8_BAR; PG8_SCHED;
            PG8_STAGE(PG8_SB(1, 1), b3 + hstep, voffB);
            PG8_WAIT_V(6); PG8_BAR; PG8_MMA(1, 1, At, B1); PG8_BAR;
            }
        }
        if constexpr (ALIGN_EPI) { if (wr == 0) PG8_BAR; }
        if constexpr (!Epi::AFTER_DRAIN) { E(acc, cur, wr, wc, fr, fq); S.done(cur); }
        if (!has_next) break;
        if (!E.keep(cur)) {
#pragma unroll
        for (int a = 0; a < 2; ++a)
#pragma unroll
            for (int b = 0; b < 2; ++b)
#pragma unroll
                for (int m = 0; m < 4; ++m)
#pragma unroll
                    for (int n = 0; n < 2; ++n) acc[a][b][m][n] = (f32x4){0.f, 0.f, 0.f, 0.f};
        }
        cur = nxt; cA = nA; cB = nB; ++ui;
        if constexpr (ALIGN_EPI) { if (wr == 1) PG8_BAR; }
    }
    PG8_WAIT_V(0);
    if constexpr (!ALIGN_EPI) { if (wr == 0) PG8_BAR; }
    PG8_BAR;
    if constexpr (Epi::AFTER_DRAIN) { E.fused(acc, cur, wr, wc, fr, fq, lds, wid, lane); S.done(cur); }
#undef PG8_SA
#undef PG8_SB
#undef PG8_STAGE
#undef PG8_LDA
#undef PG8_LDB
#undef PG8_MMA
#undef PG8_WAIT_V
#undef PG8_WAIT_L
#undef PG8_BAR
#undef PG8_SCHED
}
}

#ifndef PG8_SP2
#define PG8_SP2 true
#endif
#ifndef PG8_ALIGN
#define PG8_ALIGN true
#endif
constexpr int NWAVES = 8;
constexpr int N_PHASES = 10;
#ifndef MK_N_LAUNCHES
#define MK_N_LAUNCHES 1
#endif
constexpr int N_LAUNCHES = MK_N_LAUNCHES;
static_assert(N_LAUNCHES == 1 || N_LAUNCHES == N_PHASES, "MK_N_LAUNCHES is 1 or N_PHASES");

constexpr int BATCH = 2, SEQ = 8192, D = 2048, M = BATCH * SEQ;
constexpr int NH = 8, HD = 128, HW = NH * HD;
constexpr int NQKV = 6 * HW, NGATE = 2 * D, N1 = NQKV + NGATE;
constexpr int S_QSB = 0, S_KSB = 1, S_VSB = 2, S_QMB = 3, S_KMB = 4, S_VMB = 5;
constexpr int MB_BLK = 256, MB_NB = SEQ / MB_BLK;
constexpr int PEER_H = 8, PEER_NK = 128, PEER_K = 16, PEER_QD = 256, PEER_SEL = PEER_H * PEER_K;
constexpr float LN_EPS = 1e-5f;
constexpr float DN_ALPHA = 1.189207115002721f;
constexpr float ATT_SCALE = 0.08838834764831845f;
constexpr float LOG2E = 1.4426950408889634f;
constexpr float SB_EXIT = 1e-12f;

constexpr size_t MiB = 1u << 20;
constexpr size_t WS_CTL = 0, CTL_ZERO_BYTES = 1 * MiB;
constexpr size_t WS_KMEAN = 1 * MiB;
constexpr size_t WS_WIG = 2 * MiB;
constexpr size_t WS_WSB = 42 * MiB, WS_WMB = 46 * MiB;
constexpr size_t WS_WOUT = 50 * MiB, WS_WPQ = 58 * MiB;
constexpr size_t WS_IDS = 66 * MiB, WS_GW = 74 * MiB;
constexpr size_t WS_QKV = 96 * MiB;
constexpr size_t WS_H1 = 96 * MiB;
constexpr size_t WS_MIXED = 224 * MiB;
constexpr size_t WS_GATE = 288 * MiB;
constexpr size_t WS_QP = 288 * MiB;
constexpr size_t WS_XB = 416 * MiB;
constexpr size_t WS_OSB = 416 * MiB, WS_OMB = 448 * MiB;
constexpr size_t WS_X1B = 416 * MiB;
constexpr size_t WS_U8 = 224 * MiB, WS_V8 = 256 * MiB;
constexpr size_t WS_END = 480 * MiB;
constexpr int CW_BAR = 4096;

constexpr int RING_OFF = 0, RING_BYTES = 131072;
constexpr int LDSCTL_OFF = RING_BYTES, MISC_OFF = LDSCTL_OFF + 320;
constexpr int P9X_OFF = 147456;
constexpr int LDS_BYTES = 163840;
static_assert(MISC_OFF + 128 <= LDS_BYTES, "LDS map");

#define GAS __attribute__((address_space(1)))
#define LAS __attribute__((address_space(3)))
typedef unsigned short bf16;
typedef unsigned v4u __attribute__((ext_vector_type(4)));
typedef unsigned v2u __attribute__((ext_vector_type(2)));
typedef float f32x4 __attribute__((ext_vector_type(4)));
typedef float f32x2 __attribute__((ext_vector_type(2)));
typedef GAS unsigned gu32;
#define RLX_AGENT __ATOMIC_RELAXED, __HIP_MEMORY_SCOPE_AGENT
#define LDS_WAIT() asm volatile("s_waitcnt lgkmcnt(0)" ::: "memory")
#define VM_WAIT() asm volatile("s_waitcnt vmcnt(0)" ::: "memory")
__device__ __forceinline__ unsigned f2bf(float f) { unsigned u = __builtin_bit_cast(unsigned, f); return (u + 0x7fffu + ((u >> 16) & 1u)) >> 16; }
__device__ __forceinline__ unsigned pk2(float lo, float hi) { return f2bf(lo) | (f2bf(hi) << 16); }
__device__ __forceinline__ float bflo(unsigned w) { return __uint_as_float(w << 16); }
__device__ __forceinline__ float bfhi(unsigned w) { return __uint_as_float(w & 0xffff0000u); }

#define XB_TMO      128
#define XB_XCNT(j)  (256  + 64 * (j))
#define XB_XSUB(j)  (1280 + 64 * (j))
#define XB_XGEN(j)  (2304 + 64 * (j))
#define XB_TOP      3328
#define XB_TOPGEN   3392
#define XCD_BAR_WORDS 3456
#define XB_SPIN_CAP (1u << 18)

__device__ __forceinline__ unsigned xb_ld(unsigned* p)              { return __hip_atomic_load(p, __ATOMIC_RELAXED, __HIP_MEMORY_SCOPE_AGENT); }
__device__ __forceinline__ unsigned xb_add(unsigned* p, unsigned v) { return __hip_atomic_fetch_add(p, v, __ATOMIC_RELAXED, __HIP_MEMORY_SCOPE_AGENT); }
__device__ __forceinline__ unsigned xb_xcc_id() { return (unsigned)__builtin_amdgcn_s_getreg((3 << 11) | 20) & 0xFu; }
#define XB_SPIN(cond, bar) do { unsigned _sp = 0; while (cond) { __builtin_amdgcn_s_sleep(1); \
    if ((++_sp & 255u) == 0u) { if (xb_ld(&(bar)[XB_TMO])) break; if (_sp > XB_SPIN_CAP) { atomicAdd(&(bar)[XB_TMO], 1u); break; } } } } while (0)

struct XcdBarrier {
    unsigned* bar; unsigned x;
    volatile LAS unsigned* st;
};
__device__ __forceinline__ XcdBarrier xcd_barrier_post(unsigned* bar, volatile LAS unsigned* st) {
    XcdBarrier b; b.bar = bar; b.x = xb_xcc_id(); b.st = st;
    if (threadIdx.x == 0) (void)xb_add(&bar[XB_XCNT(b.x)], 1u);
    return b;
}
__device__ __forceinline__ void xcd_barrier_complete(unsigned* bar, unsigned x, unsigned& nloc, unsigned& nx) {
    const unsigned G = gridDim.x * gridDim.y * gridDim.z;
    unsigned sum, cnt, mine, sp = 0u;
    for (;;) {
        sum = 0u; cnt = 0u; mine = 0u;
#pragma unroll
        for (unsigned j = 0; j < 16; ++j) { const unsigned c = xb_ld(&bar[XB_XCNT(j)]); sum += c; cnt += (c > 0u) ? 1u : 0u; mine = (j == x) ? c : mine; }
        if (sum == G) break;
        __builtin_amdgcn_s_sleep(1);
        if ((++sp & 255u) == 0u) { if (xb_ld(&bar[XB_TMO])) break; if (sp > XB_SPIN_CAP) { atomicAdd(&bar[XB_TMO], 1u); break; } }
    }
    nloc = mine > 0u ? mine : 1u; nx = cnt > 0u ? cnt : 1u;
}
__device__ __forceinline__ void xcd_barrier(const XcdBarrier& b) {
    asm volatile("s_waitcnt vmcnt(0)" ::: "memory");
    __syncthreads();
    if (threadIdx.x == 0) {
        unsigned* bar = b.bar;
        __builtin_amdgcn_s_waitcnt(0);
        unsigned nloc = b.st[0], nx = b.st[1];
        if (nloc == 0u) { xcd_barrier_complete(bar, b.x, nloc, nx); b.st[0] = nloc; b.st[1] = nx; }
        const unsigned old = xb_add(&bar[XB_XSUB(b.x)], 1u);
        const unsigned gen = old / nloc;
        if (old + 1u == (gen + 1u) * nloc) {
            __builtin_amdgcn_fence(__ATOMIC_RELEASE, "agent");
            asm volatile("s_waitcnt vmcnt(0)" ::: "memory");
            const unsigned og = xb_add(&bar[XB_TOP], 1u);
            const unsigned tg = og / nx;
            if (og + 1u == (tg + 1u) * nx) xb_add(&bar[XB_TOPGEN], 1u);
            else XB_SPIN(xb_ld(&bar[XB_TOPGEN]) == tg, bar);
            __builtin_amdgcn_fence(__ATOMIC_ACQUIRE, "agent");
            xb_add(&bar[XB_XGEN(b.x)], 1u);
            asm volatile("s_waitcnt vmcnt(0)" ::: "memory");
        } else {
            XB_SPIN(xb_ld(&bar[XB_XGEN(b.x)]) == gen, bar);
            __builtin_amdgcn_fence(__ATOMIC_ACQUIRE, "agent");
            asm volatile("s_waitcnt vmcnt(0)" ::: "memory");
        }
    }
    __syncthreads();
}

struct Frame {
    LAS unsigned char* lds;
    volatile LAS unsigned* MISC;
    gu32* ctl;
    int tid, lane, wave;
    int vcu, G;
    const float *x, *w_in, *w_gate, *b_gate, *w_bsb, *w_bmb, *w_out, *rel_bias, *ln1_g, *ln1_b, *w_pq, *subkeys, *peer_u, *peer_v, *ln2_g, *ln2_b;
    float* out;
    float* KMEAN; bf16 *WIG, *WSB, *WMB, *WOUT, *WPQ; int* IDS; float* GW;
    bf16 *QKV, *MIXED, *GATE, *XB, *OSB, *OMB, *X1B, *QPB; float *H1, *QP; unsigned char *U8, *V8;
};

__device__ __forceinline__ float wave_sum(float v) {
#pragma unroll
    for (int o = 1; o < 64; o <<= 1) v += __shfl_xor(v, o);
    return v;
}
__device__ __forceinline__ float wave_max(float v) {
#pragma unroll
    for (int o = 1; o < 64; o <<= 1) v = fmaxf(v, __shfl_xor(v, o));
    return v;
}
__device__ __forceinline__ void wave_argmax(float& v, int& i) {
#pragma unroll
    for (int o = 1; o < 64; o <<= 1) { const float ov = __shfl_xor(v, o); const int oi = __shfl_xor(i, o); if (ov > v || (ov == v && oi < i)) { v = ov; i = oi; } }
}

__device__ __forceinline__ void p0_transpose_item(const float* W, int K, int N, bf16* WT, int row_off, LAS float* scr, int item, int lane) {
    const int nblk = N / 32, kb = item / nblk, nb = item % nblk, k0 = 64 * kb, n0 = 32 * nb;
    float tv[32];
#pragma unroll
    for (int i = 0; i < 32; ++i) { const int kk = 2 * i + (lane >> 5); tv[i] = W[(size_t)(k0 + kk) * N + n0 + (lane & 31)]; }
#pragma unroll
    for (int i = 0; i < 32; ++i) { const int kk = 2 * i + (lane >> 5); scr[kk * 33 + (lane & 31)] = tv[i]; }
    LDS_WAIT(); asm volatile("" ::: "memory");
    const int c = lane & 7;
#pragma unroll
    for (int j = 0; j < 4; ++j) { const int n = (lane >> 3) + 8 * j; const LAS float* s = scr + (8 * c) * 33 + n;
        v4u o; o.x = pk2(s[0 * 33], s[1 * 33]); o.y = pk2(s[2 * 33], s[3 * 33]); o.z = pk2(s[4 * 33], s[5 * 33]); o.w = pk2(s[6 * 33], s[7 * 33]);
        *(GAS v4u*)(WT + (size_t)(row_off + n0 + n) * K + k0 + 8 * c) = o; }
    LDS_WAIT(); asm volatile("" ::: "memory");
}
constexpr float W8_SCALE = 64.f;
__device__ __forceinline__ unsigned pk4_fp8(float a, float b, float c, float d) {
    int w = 0; w = __builtin_amdgcn_cvt_pk_fp8_f32(fminf(fmaxf(a, -448.f), 448.f), fminf(fmaxf(b, -448.f), 448.f), w, false);
    w = __builtin_amdgcn_cvt_pk_fp8_f32(fminf(fmaxf(c, -448.f), 448.f), fminf(fmaxf(d, -448.f), 448.f), w, true); return (unsigned)w; }
__device__ __forceinline__ void p0_transpose_item8(const float* W, int K, int N, unsigned char* WT, int row_off, LAS float* scr, int item, int lane) {
    const int nblk = N / 32, kb = item / nblk, nb = item % nblk, k0 = 64 * kb, n0 = 32 * nb;
    float tv[32];
#pragma unroll
    for (int i = 0; i < 32; ++i) { const int kk = 2 * i + (lane >> 5); tv[i] = W[(size_t)(k0 + kk) * N + n0 + (lane & 31)]; }
#pragma unroll
    for (int i = 0; i < 32; ++i) { const int kk = 2 * i + (lane >> 5); scr[kk * 33 + (lane & 31)] = tv[i] * W8_SCALE; }
    LDS_WAIT(); asm volatile("" ::: "memory");
    const int c = lane & 7;
#pragma unroll
    for (int j = 0; j < 4; ++j) { const int n = (lane >> 3) + 8 * j; const LAS float* s = scr + (8 * c) * 33 + n;
        v2u o; o.x = pk4_fp8(s[0 * 33], s[1 * 33], s[2 * 33], s[3 * 33]); o.y = pk4_fp8(s[4 * 33], s[5 * 33], s[6 * 33], s[7 * 33]);
        *(GAS v2u*)(WT + (size_t)(row_off + n0 + n) * K + k0 + 8 * c) = o; }
    LDS_WAIT(); asm volatile("" ::: "memory");
}
__device__ __forceinline__ void p0_prologue(Frame& F) {
    LAS float* scr = (LAS float*)(F.lds + RING_OFF + F.wave * 16384);
    const int gw = F.vcu * NWAVES + F.wave, NGW = F.G * NWAVES;
    constexpr int I_IN = (D / 64) * (NQKV / 32), I_G = (D / 64) * (NGATE / 32), I_B = (HW / 64) * (D / 32), I_O = (D / 64) * (D / 32);
    constexpr int NITEMS = I_IN + I_G + 2 * I_B + 2 * I_O;
    for (int it = gw; it < NITEMS; it += NGW) {
        int r = it;
        if (r < I_IN) { p0_transpose_item8(F.w_in, D, NQKV, (unsigned char*)F.WIG, 0, scr, r, F.lane); continue; } r -= I_IN;
        if (r < I_G) { p0_transpose_item8(F.w_gate, D, NGATE, (unsigned char*)F.WIG, NQKV, scr, r, F.lane); continue; } r -= I_G;
        if (r < I_B) { p0_transpose_item(F.w_bsb, HW, D, F.WSB, 0, scr, r, F.lane); continue; } r -= I_B;
        if (r < I_B) { p0_transpose_item(F.w_bmb, HW, D, F.WMB, 0, scr, r, F.lane); continue; } r -= I_B;
        if (r < I_O) { p0_transpose_item8(F.w_out, D, D, (unsigned char*)F.WOUT, 0, scr, r, F.lane); continue; } r -= I_O;
        p0_transpose_item(F.w_pq, D, D, F.WPQ, 0, scr, r, F.lane);
    }
    for (int m = gw; m < M; m += NGW) {
        const GAS f32x4* xr = (const GAS f32x4*)(F.x + (size_t)m * D) + F.lane;
        GAS unsigned* o4 = (GAS unsigned*)((unsigned char*)F.XB + (size_t)m * D) + F.lane;
#pragma unroll
        for (int j = 0; j < 8; ++j) { const f32x4 v = xr[64 * j]; o4[64 * j] = pk4_fp8(v.x, v.y, v.z, v.w); }
    }
}

__device__ __forceinline__ void p2_kmean(Frame& F) {
    const int gw = F.vcu * NWAVES + F.wave, NGW = F.G * NWAVES, lane = F.lane;
    for (int it = gw; it < BATCH * NH * MB_NB * 4; it += NGW) {
        const int q = it & 3, n = (it >> 2) % MB_NB, bh = it / (4 * MB_NB), h = bh % NH, b = bh / NH;
        const GAS v4u* kp = (const GAS v4u*)(F.QKV + ((size_t)(S_KMB * NH + h) * M + b * SEQ + n * MB_BLK + q * 64 + (lane >> 4)) * HD) + (lane & 15);
        float a[8];
#pragma unroll
        for (int i = 0; i < 8; ++i) a[i] = 0.f;
#pragma unroll
        for (int r = 0; r < 16; ++r) { const v4u w = kp[(size_t)r * 4 * (HD / 8)];
            a[0] += bflo(w.x); a[1] += bfhi(w.x); a[2] += bflo(w.y); a[3] += bfhi(w.y); a[4] += bflo(w.z); a[5] += bfhi(w.z); a[6] += bflo(w.w); a[7] += bfhi(w.w); }
#pragma unroll
        for (int i = 0; i < 8; ++i) { a[i] += __shfl_xor(a[i], 16); a[i] += __shfl_xor(a[i], 32); }
        if (lane < 16) { GAS f32x4* o = (GAS f32x4*)(F.KMEAN + (size_t)it * HD + 8 * lane); o[0] = (f32x4){a[0], a[1], a[2], a[3]}; o[1] = (f32x4){a[4], a[5], a[6], a[7]}; }
    }
}

__device__ __forceinline__ int rel_bucket(int rel) {
    if (rel < 16) return rel;
    int b = 16;
    b += rel >= 21; b += rel >= 27; b += rel >= 35; b += rel >= 46; b += rel >= 59; b += rel >= 77; b += rel >= 99; b += rel >= 128;
    b += rel >= 166; b += rel >= 216; b += rel >= 280; b += rel >= 363; b += rel >= 470; b += rel >= 609; b += rel >= 790;
    return b;
}

namespace mb {
typedef short bf16x8 __attribute__((ext_vector_type(8)));
typedef short s16x4 __attribute__((ext_vector_type(4)));
typedef float f32x16 __attribute__((ext_vector_type(16)));
typedef unsigned u32x4 __attribute__((ext_vector_type(4)));
#define MB_KSWZ(row, colB) ((row) * 256 + ((colB) ^ (((row) & 7) << 4)))
__device__ __forceinline__ int v_st(int k, int c) { const int kk = (k & ~0xC) | ((k & 4) << 1) | ((k & 8) >> 1); return ((kk >> 3) * 4 + (c >> 5)) * 512 + ((kk & 7) * 32 + (c & 31)) * 2; }
__device__ __forceinline__ int v_rd_base(int lane) { return ((lane & 3) << 3) | (((lane >> 2) & 3) << 6) | (((lane >> 4) & 1) << 5) | (((lane >> 5) & 1) << 8); }
constexpr int v_rd_off(int d0, int ks, int half) { return d0 * 512 + ks * 4096 + half * 2048; }
__device__ __forceinline__ int crow(int r, int hi) { return (r & 3) + 8 * (r >> 2) + 4 * hi; }
__device__ __forceinline__ unsigned cvtpk(float lo, float hi) { unsigned r; asm volatile("v_cvt_pk_bf16_f32 %0, %1, %2" : "=v"(r) : "v"(lo), "v"(hi)); return r; }
constexpr int EXT = 131584;
constexpr int X_SEL = EXT, X_LISTS = EXT + 1024, X_CNT = EXT + 9216, X_UNITS = EXT + 9344, X_CTR = EXT + 9472, X_LUT = EXT + 9488, X_WS = EXT + 12688, X_END = EXT + 14736;
constexpr int LUTN = 800;
}
static_assert(mb::X_END <= LDS_BYTES, "MoBA LDS map");
constexpr size_t WS_PML = WS_IDS;

__device__ __forceinline__ void p3_moba(Frame& F) {
    using namespace mb;
    LAS unsigned char* const lds = F.lds;
    LAS float* const KM = (LAS float*)lds;
    LAS float* const GT = (LAS float*)(lds + 16384);
    LAS unsigned char* const SEL = lds + X_SEL;
    LAS unsigned char* const LISTS = lds + X_LISTS;
    LAS int* const CNT = (LAS int*)(lds + X_CNT);
    LAS unsigned short* const UNITS = (LAS unsigned short*)(lds + X_UNITS);
    LAS int* const CTR = (LAS int*)(lds + X_CTR);
    LAS float* const LUT = (LAS float*)(lds + X_LUT);
    LAS float* const WS = (LAS float*)(lds + X_WS) + F.wave * 64;
    LAS unsigned char* const Kl = lds + F.wave * 16384;
    LAS unsigned char* const Vl = Kl + 8192;
    const int tid = F.tid, lane = F.lane, wave = F.wave, r32 = lane & 31, hi = lane >> 5;
    float* const PO = F.out + (size_t)blockIdx.x * (256 * 4 * 128);
    float* const PML = (float*)((unsigned char*)F.ctl + WS_PML) + (size_t)blockIdx.x * (256 * 4 * 2);
    constexpr float C2 = ATT_SCALE * LOG2E;
    for (int item = F.vcu; item < BATCH * NH * MB_NB; item += F.G) {
        const int pass = item / (BATCH * NH * MB_NB / 2), ii = item % (BATCH * NH * MB_NB / 2);
        const int grp = ii / MB_NB, cix = ii % MB_NB;
        const int bh = (grp + 8 * pass) % (BATCH * NH), qb = pass ? (MB_NB - 1 - cix) : cix, h = bh % NH, b = bh / NH;
        const int nsel = qb < 3 ? qb : 3;
        const bf16* const Qb = F.QKV + ((size_t)(S_QMB * NH + h) * M + b * SEQ + qb * MB_BLK) * HD;
        const bf16* const Kh = F.QKV + ((size_t)(S_KMB * NH + h) * M + b * SEQ) * HD;
        const bf16* const Vh = F.QKV + ((size_t)(S_VMB * NH + h) * M + b * SEQ) * HD;
        __syncthreads();
        for (int i = tid; i < qb * HD; i += NWAVES * 64) { const float* kq = F.KMEAN + ((size_t)(bh * MB_NB + (i >> 7)) * 4) * HD + (i & 127);
            KM[i] = ((kq[0] + kq[HD]) + (kq[2 * HD] + kq[3 * HD])) * (1.0f / MB_BLK); }
        for (int i = tid; i < LUTN; i += NWAVES * 64) LUT[i] = F.rel_bias[h * 32 + rel_bucket(i)];
        if (tid < 32) CNT[tid] = 0;
        if (tid == 0) CTR[1] = 0;
        __syncthreads();
        if (qb > 0) {
            const int i = tid & 255, nh = tid >> 8; const int jmax = qb - nh * 16;
            float acc[16];
#pragma unroll
            for (int j = 0; j < 16; ++j) acc[j] = 0.f;
            const GAS v4u* qp = (const GAS v4u*)(Qb + (size_t)i * HD);
            for (int dc = 0; dc < 16; ++dc) {
                const v4u qw = qp[dc];
                const float q0 = bflo(qw.x), q1 = bfhi(qw.x), q2 = bflo(qw.y), q3 = bfhi(qw.y), q4 = bflo(qw.z), q5 = bfhi(qw.z), q6 = bflo(qw.w), q7 = bfhi(qw.w);
#pragma unroll
                for (int j = 0; j < 16; ++j) if (j < jmax) { const LAS f32x4* kp = (const LAS f32x4*)(KM + (nh * 16 + j) * HD + dc * 8); const f32x4 a = kp[0], c = kp[1];
                    acc[j] += q0 * a.x + q1 * a.y + q2 * a.z + q3 * a.w + q4 * c.x + q5 * c.y + q6 * c.z + q7 * c.w; }
            }
#pragma unroll
            for (int j = 0; j < 16; ++j) if (j < jmax) GT[i * 33 + nh * 16 + j] = acc[j];
        }
        __syncthreads();
        if (tid < 256) {
            unsigned chosen = 0u;
#pragma unroll
            for (int r = 0; r < 3; ++r) {
                int bi = 255;
                if (r < nsel) { float best = -3.0e38f; bi = 0;
                    for (int n = 0; n < qb; ++n) { const float v = GT[tid * 33 + n]; if (!((chosen >> n) & 1u) && v > best) { best = v; bi = n; } }
                    chosen |= 1u << bi;
                    const int pos = __hip_atomic_fetch_add(CNT + bi, 1, __ATOMIC_RELAXED, __HIP_MEMORY_SCOPE_WORKGROUP);
                    LISTS[bi * 256 + pos] = (unsigned char)tid; }
                SEL[tid * 4 + r] = (unsigned char)bi;
            }
        }
        __syncthreads();
        if (wave == 0) {
            const int nun = (lane < qb) ? ((CNT[lane & 31] + 31) >> 5) : 0; int pre = nun;
#pragma unroll
            for (int o = 1; o < 32; o <<= 1) { const int v = __shfl_up(pre, o); if ((lane & 31) >= o) pre += v; }
            const int tot = __shfl(pre, 31); pre -= nun;
            if (lane < 32) for (int k = 0; k < nun; ++k) UNITS[pre + k] = (unsigned short)(lane | (k << 5));
            if (lane < 8) UNITS[tot + lane] = (unsigned short)(0x8000 | (7 - lane));
            if (lane == 0) CTR[0] = tot + 8; }
        __syncthreads();
        const int NU = CTR[0];
        for (;;) {
            int u = 0; if (lane == 0) u = __hip_atomic_fetch_add(CTR + 1, 1, __ATOMIC_RELAXED, __HIP_MEMORY_SCOPE_WORKGROUP);
            u = __builtin_amdgcn_readfirstlane(u);
            if (u >= NU) break;
            const int code = UNITS[u]; const bool own = (code & 0x8000) != 0;
            const int n = own ? qb : (code & 31), ch = own ? (code & 7) : ((code >> 5) & 7);
            int qi, valid = 1, slot = 3;
            if (own) { qi = ch * 32 + r32; }
            else { const int c = CNT[n]; int e = ch * 32 + r32; if (e >= c) { e = c - 1; valid = 0; } qi = LISTS[n * 256 + e];
                   slot = (SEL[qi * 4] == n) ? 0 : ((SEL[qi * 4 + 1] == n) ? 1 : 2); }
            const int nst = own ? (ch + 1) : 8;
            const bool far = !own && (qb - n >= 5);
            const float cfar = LUT[LUTN - 1] * LOG2E;
            const int rel00 = (qb - n) * MB_BLK + qi - 4 * hi;
            bf16x8 qr[8];
            { const bf16* qrow = Qb + (size_t)qi * HD + hi * 8;
#pragma unroll
              for (int d0 = 0; d0 < 8; ++d0) qr[d0] = *(const GAS bf16x8*)(qrow + d0 * 16); }
            const bf16* const Kt = Kh + (size_t)(n * MB_BLK + (lane >> 4)) * HD + (lane & 15) * 8;
            const bf16* const Vt = Vh + (size_t)(n * MB_BLK + (lane >> 4)) * HD + (lane & 15) * 8;
            v4u sreg[8];
#define MB_LOADT(P_, j) do { _Pragma("unroll") for (int i_ = 0; i_ < 8; ++i_) sreg[i_] = *(const GAS v4u*)((P_) + (size_t)((j) * 32 + 4 * i_) * HD); } while (0)
            MB_LOADT(Kt, 0);
            f32x16 o[4] = {}; float m_reg = -1e30f, l_reg = 0.f;
            const int kw0 = MB_KSWZ(lane >> 4, (lane & 15) * 16);
            const int vb0 = (int)(uintptr_t)Vl + v_rd_base(lane);
            LAS const unsigned char* kb[4];
#pragma unroll
            for (int dd = 0; dd < 4; ++dd) kb[dd] = Kl + MB_KSWZ(r32, (dd * 16 + hi * 8) * 2);
            for (int j = 0; j < nst; ++j) {
#pragma unroll
                for (int i_ = 0; i_ < 8; ++i_) { const int row = (lane >> 4) + 4 * i_; *(LAS v4u*)(Kl + MB_KSWZ(row, (lane & 15) * 16)) = sreg[i_]; }
                asm volatile("s_waitcnt lgkmcnt(0)" ::: "memory");
                __builtin_amdgcn_sched_barrier(0);
                MB_LOADT(Vt, j);
                __builtin_amdgcn_sched_barrier(0);
                f32x16 p = {};
#pragma unroll
                for (int d0 = 0; d0 < 8; ++d0) { const bf16x8 kf = *(const LAS bf16x8*)(kb[d0 & 3] + (d0 >> 2) * 128); p = __builtin_amdgcn_mfma_f32_32x32x16_bf16(kf, qr[d0], p, 0, 0, 0); }
                if (far) {
#pragma unroll
                    for (int r = 0; r < 16; ++r) p[r] = fmaf(p[r], C2, cfar);
                } else {
                    const int relj = rel00 - 32 * j;
                    float bs[16];
#pragma unroll
                    for (int r = 0; r < 16; ++r) { const int rel = relj - ((r & 3) + 8 * (r >> 2)); bs[r] = LUT[rel < 0 ? 0 : (rel > LUTN - 1 ? LUTN - 1 : rel)]; }
                    asm volatile("s_waitcnt lgkmcnt(0)" : "+v"(bs[0]), "+v"(bs[1]), "+v"(bs[2]), "+v"(bs[3]), "+v"(bs[4]), "+v"(bs[5]), "+v"(bs[6]), "+v"(bs[7]),
                                 "+v"(bs[8]), "+v"(bs[9]), "+v"(bs[10]), "+v"(bs[11]), "+v"(bs[12]), "+v"(bs[13]), "+v"(bs[14]), "+v"(bs[15]) :: "memory");
#pragma unroll
                    for (int r = 0; r < 16; ++r) { const int rel = relj - ((r & 3) + 8 * (r >> 2)); const float v = fmaf(p[r], C2, bs[r] * LOG2E); p[r] = (rel >= 0) ? v : -__builtin_inff(); }
                }
                float pmax = fmaxf(fmaxf(fmaxf(fmaxf(p[0], p[1]), fmaxf(p[2], p[3])), fmaxf(fmaxf(p[4], p[5]), fmaxf(p[6], p[7]))),
                                   fmaxf(fmaxf(fmaxf(p[8], p[9]), fmaxf(p[10], p[11])), fmaxf(fmaxf(p[12], p[13]), fmaxf(p[14], p[15]))));
                { auto rr = __builtin_amdgcn_permlane32_swap(__float_as_uint(pmax), __float_as_uint(pmax), false, false); pmax = fmaxf(__uint_as_float(rr[0]), __uint_as_float(rr[1])); }
                float mn, alpha;
                if (__all(pmax - m_reg <= 8.0f)) { mn = m_reg; alpha = 1.f; }
                else { mn = fmaxf(m_reg, pmax); alpha = __builtin_amdgcn_exp2f(m_reg - mn); m_reg = mn; }
#pragma unroll
                for (int r = 0; r < 16; ++r) p[r] = __builtin_amdgcn_exp2f(p[r] - mn);
                float ps = (((p[0] + p[1]) + (p[2] + p[3])) + ((p[4] + p[5]) + (p[6] + p[7]))) + (((p[8] + p[9]) + (p[10] + p[11])) + ((p[12] + p[13]) + (p[14] + p[15])));
                { auto rr = __builtin_amdgcn_permlane32_swap(__float_as_uint(ps), __float_as_uint(ps), false, false); ps = __uint_as_float(rr[0]) + __uint_as_float(rr[1]); }
                l_reg = l_reg * alpha + ps;
                if (__any(alpha < 1.f)) {
                    if (hi == 0) WS[r32] = alpha;
                    asm volatile("s_waitcnt lgkmcnt(0)" ::: "memory");
#pragma unroll
                    for (int r = 0; r < 16; ++r) { const float a = WS[crow(r, hi)];
#pragma unroll
                        for (int d_ = 0; d_ < 4; ++d_) o[d_][r] *= a; }
                }
                bf16x8 pa0, pa1;
#define MB_PK4(P, B_, OUT) do { unsigned a0 = cvtpk(P[B_+0], P[B_+1]), a1 = cvtpk(P[B_+2], P[B_+3]); unsigned b0 = cvtpk(P[B_+4], P[B_+5]), b1 = cvtpk(P[B_+6], P[B_+7]); \
        auto r0 = __builtin_amdgcn_permlane32_swap(a0, b0, false, false); auto r1 = __builtin_amdgcn_permlane32_swap(a1, b1, false, false); \
        u32x4 w = {r0[0], r1[0], r0[1], r1[1]}; OUT = *reinterpret_cast<bf16x8*>(&w); } while (0)
                MB_PK4(p, 0, pa0); MB_PK4(p, 8, pa1);
                __builtin_amdgcn_sched_barrier(0);
#pragma unroll
                for (int i_ = 0; i_ < 8; ++i_) { const int row = (lane >> 4) + 4 * i_; *(LAS v4u*)(Vl + v_st(row, (lane & 15) * 8)) = sreg[i_]; }
                asm volatile("s_waitcnt lgkmcnt(0)" ::: "memory");
                __builtin_amdgcn_sched_barrier(0);
                if (j + 1 < nst) MB_LOADT(Kt, j + 1);
                __builtin_amdgcn_sched_barrier(0);
#define MB_TRRD(dst, off) asm volatile("ds_read_b64_tr_b16 %0, %1 offset:%2" : "=&v"(dst) : "v"(vb0), "i"(off) : "memory")
#define MB_PV(d0) do { s16x4 l0, l1, h0, h1; constexpr int b_ = v_rd_off(d0, 0, 0); \
        MB_TRRD(l0, b_); MB_TRRD(h0, b_ + 2048); MB_TRRD(l1, b_ + 4096); MB_TRRD(h1, b_ + 6144); \
        asm volatile("s_waitcnt lgkmcnt(0)" ::: "memory"); __builtin_amdgcn_sched_barrier(0); \
        o[d0] = __builtin_amdgcn_mfma_f32_32x32x16_bf16(pa0, (bf16x8){l0[0], l0[1], l0[2], l0[3], h0[0], h0[1], h0[2], h0[3]}, o[d0], 0, 0, 0); \
        o[d0] = __builtin_amdgcn_mfma_f32_32x32x16_bf16(pa1, (bf16x8){l1[0], l1[1], l1[2], l1[3], h1[0], h1[1], h1[2], h1[3]}, o[d0], 0, 0, 0); } while (0)
                { s16x4 vl[4][4];
#define MB_TR4(d0) do { constexpr int b_ = v_rd_off(d0, 0, 0); MB_TRRD(vl[d0][0], b_); MB_TRRD(vl[d0][1], b_ + 2048); MB_TRRD(vl[d0][2], b_ + 4096); MB_TRRD(vl[d0][3], b_ + 6144); } while (0)
                  MB_TR4(0); MB_TR4(1); MB_TR4(2); MB_TR4(3);
                  asm volatile("s_waitcnt lgkmcnt(0)" ::: "memory"); __builtin_amdgcn_sched_barrier(0);
#pragma unroll
                  for (int d0 = 0; d0 < 4; ++d0) {
                      o[d0] = __builtin_amdgcn_mfma_f32_32x32x16_bf16(pa0, (bf16x8){vl[d0][0][0], vl[d0][0][1], vl[d0][0][2], vl[d0][0][3], vl[d0][1][0], vl[d0][1][1], vl[d0][1][2], vl[d0][1][3]}, o[d0], 0, 0, 0);
                      o[d0] = __builtin_amdgcn_mfma_f32_32x32x16_bf16(pa1, (bf16x8){vl[d0][2][0], vl[d0][2][1], vl[d0][2][2], vl[d0][2][3], vl[d0][3][0], vl[d0][3][1], vl[d0][3][2], vl[d0][3][3]}, o[d0], 0, 0, 0); }
#undef MB_TR4
                }
            }
            if (hi == 0) ((LAS int*)WS)[32 + r32] = valid ? (qi * 4 + slot) : -1;
            asm volatile("s_waitcnt lgkmcnt(0)" ::: "memory");
#pragma unroll
            for (int r = 0; r < 16; ++r) { const int ri = ((LAS int*)WS)[32 + crow(r, hi)];
                if (ri >= 0) { float* dst = PO + (size_t)ri * 128 + r32;
#pragma unroll
                    for (int d_ = 0; d_ < 4; ++d_) dst[d_ * 32] = o[d_][r]; } }
            if (hi == 0 && valid) { float* ml = PML + (size_t)(qi * 4 + slot) * 2; ml[0] = m_reg; ml[1] = l_reg; }
            asm volatile("s_waitcnt lgkmcnt(0)" ::: "memory");
        }
        asm volatile("s_waitcnt vmcnt(0)" ::: "memory");
        __syncthreads();
        if (tid == 0) { __builtin_amdgcn_fence(__ATOMIC_ACQUIRE, "agent"); asm volatile("s_waitcnt vmcnt(0)" ::: "memory"); }
        __syncthreads();
        {
            const int qs = lane >> 4, dl = lane & 15;
#pragma unroll 2
            for (int it = 0; it < 8; ++it) {
                const int i = wave * 32 + 4 * it + qs;
                f32x2 ml[4]; f32x4 oa[4], ob[4];
#pragma unroll
                for (int s2 = 0; s2 < 4; ++s2) { const bool ok = (s2 == 3) || (s2 < nsel);
                    if (ok) { ml[s2] = *(const GAS f32x2*)(PML + (size_t)(i * 4 + s2) * 2); const GAS f32x4* src = (const GAS f32x4*)(PO + (size_t)(i * 4 + s2) * 128 + 8 * dl); oa[s2] = src[0]; ob[s2] = src[1]; }
                    else { ml[s2] = (f32x2){-3.0e38f, 0.f}; oa[s2] = (f32x4){0.f, 0.f, 0.f, 0.f}; ob[s2] = oa[s2]; } }
                const float mx = fmaxf(fmaxf(ml[0].x, ml[1].x), fmaxf(ml[2].x, ml[3].x));
                float L = 0.f; f32x4 ra = {0.f, 0.f, 0.f, 0.f}, rb = ra;
#pragma unroll
                for (int s2 = 0; s2 < 4; ++s2) { const float w = __builtin_amdgcn_exp2f(ml[s2].x - mx); L += w * ml[s2].y; ra = ra + oa[s2] * w; rb = rb + ob[s2] * w; }
                const float inv = 1.0f / L;
                v4u o; o.x = pk2(ra.x * inv, ra.y * inv); o.y = pk2(ra.z * inv, ra.w * inv); o.z = pk2(rb.x * inv, rb.y * inv); o.w = pk2(rb.z * inv, rb.w * inv);
                *(GAS v4u*)(F.OMB + (size_t)(b * SEQ + qb * MB_BLK + i) * HW + h * HD + 8 * dl) = o;
            }
        }
    }
#undef MB_LOADT
#undef MB_PK4
#undef MB_TRRD
#undef MB_PV
}


__device__ __forceinline__ void p2_sb(Frame& F) {
    using namespace mb;
    const int lane = F.lane, wave = F.wave, r32 = lane & 31, hi = lane >> 5;
    LAS unsigned char* const Kl = F.lds + wave * 16384;
    LAS unsigned char* const Vl = Kl + 8192;
    const int gw = F.vcu * NWAVES + wave, NGW = F.G * NWAVES;
    constexpr float C2 = ATT_SCALE * LOG2E;
    const int vb0 = (int)(uintptr_t)Vl + v_rd_base(lane);
    __syncthreads();
    for (int u = gw; u < BATCH * NH * (SEQ / 32); u += NGW) {
        const int bh = u / (SEQ / 32), qt = u % (SEQ / 32), h = bh % NH, b = bh / NH;
        const bf16* const Qb = F.QKV + ((size_t)(S_QSB * NH + h) * M + b * SEQ + qt * 32) * HD;
        const bf16* const Kt = F.QKV + ((size_t)(S_KSB * NH + h) * M + b * SEQ + (lane >> 4)) * HD + (lane & 15) * 8;
        const bf16* const Vt = F.QKV + ((size_t)(S_VSB * NH + h) * M + b * SEQ + (lane >> 4)) * HD + (lane & 15) * 8;
        bf16x8 qr[8];
        { const bf16* qrow = Qb + (size_t)r32 * HD + hi * 8;
#pragma unroll
          for (int d0 = 0; d0 < 8; ++d0) qr[d0] = *(const GAS bf16x8*)(qrow + d0 * 16); }
        v4u sreg[8];
#define SB_LOADT(P_, j) do { _Pragma("unroll") for (int i_ = 0; i_ < 8; ++i_) sreg[i_] = *(const GAS v4u*)((P_) + (size_t)((j) * 32 + 4 * i_) * HD); } while (0)
        SB_LOADT(Kt, qt);
        f32x16 o[4] = {}; float carry = 1.f;
        LAS const unsigned char* kb[4];
#pragma unroll
        for (int dd = 0; dd < 4; ++dd) kb[dd] = Kl + MB_KSWZ(r32, (dd * 16 + hi * 8) * 2);
        for (int j = qt; j >= 0; --j) {
#pragma unroll
            for (int i_ = 0; i_ < 8; ++i_) { const int row = (lane >> 4) + 4 * i_; *(LAS v4u*)(Kl + MB_KSWZ(row, (lane & 15) * 16)) = sreg[i_]; }
            asm volatile("s_waitcnt lgkmcnt(0)" ::: "memory");
            __builtin_amdgcn_sched_barrier(0);
            SB_LOADT(Vt, j);
            __builtin_amdgcn_sched_barrier(0);
            f32x16 p = {};
#pragma unroll
            for (int d0 = 0; d0 < 8; ++d0) { const bf16x8 kf = *(const LAS bf16x8*)(kb[d0 & 3] + (d0 >> 2) * 128); p = __builtin_amdgcn_mfma_f32_32x32x16_bf16(kf, qr[d0], p, 0, 0, 0); }
            float om[16];
            const bool diag = (j == qt);
#pragma unroll
            for (int r = 0; r < 16; ++r) { const float z = fminf(fmaxf(p[r] * C2, -100.f), 100.f); const float e = __builtin_amdgcn_exp2f(-z); float be = __builtin_amdgcn_rcpf(1.0f + e); float ob = e * be;
                if (diag && crow(r, hi) >= r32) { be = 0.f; ob = 1.f; }
                p[r] = be; om[r] = ob; }
            float gp[4], go[4];
#pragma unroll
            for (int g = 0; g < 4; ++g) gp[g] = (om[4 * g] * om[4 * g + 1]) * (om[4 * g + 2] * om[4 * g + 3]);
#pragma unroll
            for (int g = 0; g < 4; ++g) { auto rr = __builtin_amdgcn_permlane32_swap(__float_as_uint(gp[g]), __float_as_uint(gp[g]), false, false); go[g] = __uint_as_float(hi ? rr[0] : rr[1]); }
            float suf = carry;
#pragma unroll
            for (int g = 3; g >= 0; --g) {
                float e_ = hi ? suf : suf * go[g];
                p[4 * g + 3] *= e_; e_ *= om[4 * g + 3];
                p[4 * g + 2] *= e_; e_ *= om[4 * g + 2];
                p[4 * g + 1] *= e_; e_ *= om[4 * g + 1];
                p[4 * g] *= e_;
                suf *= gp[g] * go[g];
            }
            carry = suf;
            bf16x8 pa0, pa1;
#define SB_PK4(P, B_, OUT) do { unsigned a0 = cvtpk(P[B_+0], P[B_+1]), a1 = cvtpk(P[B_+2], P[B_+3]); unsigned b0 = cvtpk(P[B_+4], P[B_+5]), b1 = cvtpk(P[B_+6], P[B_+7]); \
        auto r0 = __builtin_amdgcn_permlane32_swap(a0, b0, false, false); auto r1 = __builtin_amdgcn_permlane32_swap(a1, b1, false, false); \
        u32x4 w = {r0[0], r1[0], r0[1], r1[1]}; OUT = *reinterpret_cast<bf16x8*>(&w); } while (0)
            SB_PK4(p, 0, pa0); SB_PK4(p, 8, pa1);
            __builtin_amdgcn_sched_barrier(0);
#pragma unroll
            for (int i_ = 0; i_ < 8; ++i_) { const int row = (lane >> 4) + 4 * i_; *(LAS v4u*)(Vl + v_st(row, (lane & 15) * 8)) = sreg[i_]; }
            asm volatile("s_waitcnt lgkmcnt(0)" ::: "memory");
            __builtin_amdgcn_sched_barrier(0);
            const bool more = (j > 0) && !__all(carry < SB_EXIT);
            if (more) SB_LOADT(Kt, j - 1);
            __builtin_amdgcn_sched_barrier(0);
#define SB_TRRD(dst, off) asm volatile("ds_read_b64_tr_b16 %0, %1 offset:%2" : "=&v"(dst) : "v"(vb0), "i"(off) : "memory")
#define SB_PV(d0) do { s16x4 l0, l1, h0, h1; constexpr int b_ = v_rd_off(d0, 0, 0); \
        SB_TRRD(l0, b_); SB_TRRD(h0, b_ + 2048); SB_TRRD(l1, b_ + 4096); SB_TRRD(h1, b_ + 6144); \
        asm volatile("s_waitcnt lgkmcnt(0)" ::: "memory"); __builtin_amdgcn_sched_barrier(0); \
        o[d0] = __builtin_amdgcn_mfma_f32_32x32x16_bf16(pa0, (bf16x8){l0[0], l0[1], l0[2], l0[3], h0[0], h0[1], h0[2], h0[3]}, o[d0], 0, 0, 0); \
        o[d0] = __builtin_amdgcn_mfma_f32_32x32x16_bf16(pa1, (bf16x8){l1[0], l1[1], l1[2], l1[3], h1[0], h1[1], h1[2], h1[3]}, o[d0], 0, 0, 0); } while (0)
            { s16x4 vl[4][4];
#define SB_TR4(d0) do { constexpr int b_ = v_rd_off(d0, 0, 0); SB_TRRD(vl[d0][0], b_); SB_TRRD(vl[d0][1], b_ + 2048); SB_TRRD(vl[d0][2], b_ + 4096); SB_TRRD(vl[d0][3], b_ + 6144); } while (0)
              SB_TR4(0); SB_TR4(1); SB_TR4(2); SB_TR4(3);
              asm volatile("s_waitcnt lgkmcnt(0)" ::: "memory"); __builtin_amdgcn_sched_barrier(0);
#pragma unroll
              for (int d0 = 0; d0 < 4; ++d0) {
                  o[d0] = __builtin_amdgcn_mfma_f32_32x32x16_bf16(pa0, (bf16x8){vl[d0][0][0], vl[d0][0][1], vl[d0][0][2], vl[d0][0][3], vl[d0][1][0], vl[d0][1][1], vl[d0][1][2], vl[d0][1][3]}, o[d0], 0, 0, 0);
                  o[d0] = __builtin_amdgcn_mfma_f32_32x32x16_bf16(pa1, (bf16x8){vl[d0][2][0], vl[d0][2][1], vl[d0][2][2], vl[d0][2][3], vl[d0][3][0], vl[d0][3][1], vl[d0][3][2], vl[d0][3][3]}, o[d0], 0, 0, 0); }
#undef SB_TR4
            }
            if (!more) break;
        }
        bf16* const Ob = F.OSB + (size_t)(b * SEQ + qt * 32) * HW + h * HD;
#pragma unroll
        for (int r = 0; r < 16; ++r) { const int orow = crow(r, hi);
#pragma unroll
            for (int d0 = 0; d0 < 4; ++d0) { const float v = o[d0][r]; const float vn = __shfl_xor(v, 1);
                if ((r32 & 1) == 0) *(GAS unsigned*)(Ob + (size_t)orow * HW + d0 * 32 + r32) = cvtpk(v, vn); } }
    }
#undef SB_LOADT
#undef SB_PK4
#undef SB_TRRD
#undef SB_PV
}

__device__ __forceinline__ void p6_ln1(Frame& F) {
    const int gw = F.vcu * NWAVES + F.wave, NGW = F.G * NWAVES;
    for (int m = gw; m < M; m += NGW) {
        GAS f32x4* xr = (GAS f32x4*)(F.H1 + (size_t)m * D) + F.lane;
        f32x4 v[8]; float s = 0.f;
#pragma unroll
        for (int j = 0; j < 8; ++j) { v[j] = xr[64 * j]; s += (v[j].x + v[j].y) + (v[j].z + v[j].w); }
        const float mean = wave_sum(s) * (1.f / D); float s2 = 0.f;
#pragma unroll
        for (int j = 0; j < 8; ++j) { v[j] = v[j] - mean; s2 += (v[j].x * v[j].x + v[j].y * v[j].y) + (v[j].z * v[j].z + v[j].w * v[j].w); }
        const float rstd = 1.f / sqrtf(wave_sum(s2) * (1.f / D) + LN_EPS);
        GAS v2u* o8 = (GAS v2u*)(F.X1B + (size_t)m * D) + F.lane;
#pragma unroll
        for (int j = 0; j < 8; ++j) { const f32x4 gg = *((const GAS f32x4*)F.ln1_g + F.lane + 64 * j), bb = *((const GAS f32x4*)F.ln1_b + F.lane + 64 * j);
            const f32x4 y = v[j] * rstd * gg + bb; xr[64 * j] = y; v2u w; w.x = pk2(y.x, y.y); w.y = pk2(y.z, y.w); o8[64 * j] = w; }
    }
}

typedef float f32x16v __attribute__((ext_vector_type(16)));
typedef float f32x32v __attribute__((ext_vector_type(32)));
typedef unsigned u32x6v __attribute__((ext_vector_type(6)));
typedef unsigned v4u_a4 __attribute__((ext_vector_type(4), aligned(4)));
typedef unsigned v2u_a4 __attribute__((ext_vector_type(2), aligned(4)));
constexpr float U6_SCALE = 90.f, V6_SCALE = 38.f;
constexpr int ROW6 = D * 6 / 8;
constexpr int ROW4 = D / 2;
__device__ __forceinline__ void p6_tables(Frame& F) {
    const size_t gt = (size_t)F.vcu * (NWAVES * 64) + F.tid, NGT = (size_t)F.G * (NWAVES * 64);
    constexpr size_t NCH = (size_t)PEER_NK * PEER_NK * D / 32;
    for (size_t c = gt; c < 2 * NCH; c += NGT) {
        const bool isv = c >= NCH; const size_t cc = isv ? c - NCH : c;
        const GAS f32x4* src = (const GAS f32x4*)((isv ? F.peer_v : F.peer_u) + cc * 32);
        {
            v4u o;
#pragma unroll
            for (int k = 0; k < 4; ++k) { const f32x4 va = src[2 * k], vb = src[2 * k + 1]; unsigned w = 0u;
                const float sc = isv ? V6_SCALE : U6_SCALE;
                const float e0 = fminf(fmaxf(va[0] * sc, -6.f), 6.f), e1 = fminf(fmaxf(va[1] * sc, -6.f), 6.f), e2 = fminf(fmaxf(va[2] * sc, -6.f), 6.f), e3 = fminf(fmaxf(va[3] * sc, -6.f), 6.f);
                const float e4 = fminf(fmaxf(vb[0] * sc, -6.f), 6.f), e5 = fminf(fmaxf(vb[1] * sc, -6.f), 6.f), e6 = fminf(fmaxf(vb[2] * sc, -6.f), 6.f), e7 = fminf(fmaxf(vb[3] * sc, -6.f), 6.f);
                w = __builtin_amdgcn_cvt_scalef32_pk_fp4_f32(w, e0, e1, 1.0f, 0); w = __builtin_amdgcn_cvt_scalef32_pk_fp4_f32(w, e2, e3, 1.0f, 1);
                w = __builtin_amdgcn_cvt_scalef32_pk_fp4_f32(w, e4, e5, 1.0f, 2); w = __builtin_amdgcn_cvt_scalef32_pk_fp4_f32(w, e6, e7, 1.0f, 3);
                o[k] = w; }
            *(GAS v4u*)((isv ? F.V8 : F.U8) + cc * 16) = o;
        }
    }
}


namespace rt {
typedef short bf16x8 __attribute__((ext_vector_type(8)));
typedef float f32x16 __attribute__((ext_vector_type(16)));
#define RT_KSWZ(row, colB) ((row) * 256 + ((colB) ^ (((row) & 7) << 4)))
constexpr float NEGV = -3.0e38f;
}
__device__ __forceinline__ void sort16_desc(float (&v)[16]) {
#define CE(a, b) do { const float hi_ = fmaxf(a, b), lo_ = fminf(a, b); a = hi_; b = lo_; } while (0)
    CE(v[0], v[1]); CE(v[3], v[2]); CE(v[4], v[5]); CE(v[7], v[6]); CE(v[8], v[9]); CE(v[11], v[10]); CE(v[12], v[13]); CE(v[15], v[14]); CE(v[0], v[2]); CE(v[1], v[3]); CE(v[6], v[4]); CE(v[7], v[5]); CE(v[8], v[10]); CE(v[9], v[11]); CE(v[14], v[12]); CE(v[15], v[13]); CE(v[0], v[1]); CE(v[2], v[3]); CE(v[5], v[4]); CE(v[7], v[6]); CE(v[8], v[9]); CE(v[10], v[11]); CE(v[13], v[12]); CE(v[15], v[14]); CE(v[0], v[4]); CE(v[1], v[5]); CE(v[2], v[6]); CE(v[3], v[7]); CE(v[12], v[8]); CE(v[13], v[9]); CE(v[14], v[10]); CE(v[15], v[11]); CE(v[0], v[2]); CE(v[1], v[3]); CE(v[4], v[6]); CE(v[5], v[7]); CE(v[10], v[8]); CE(v[11], v[9]); CE(v[14], v[12]); CE(v[15], v[13]); CE(v[0], v[1]); CE(v[2], v[3]); CE(v[4], v[5]); CE(v[6], v[7]); CE(v[9], v[8]); CE(v[11], v[10]); CE(v[13], v[12]); CE(v[15], v[14]); CE(v[0], v[8]); CE(v[1], v[9]); CE(v[2], v[10]); CE(v[3], v[11]); CE(v[4], v[12]); CE(v[5], v[13]); CE(v[6], v[14]); CE(v[7], v[15]); CE(v[0], v[4]); CE(v[1], v[5]); CE(v[2], v[6]); CE(v[3], v[7]); CE(v[8], v[12]); CE(v[9], v[13]); CE(v[10], v[14]); CE(v[11], v[15]); CE(v[0], v[2]); CE(v[1], v[3]); CE(v[4], v[6]); CE(v[5], v[7]); CE(v[8], v[10]); CE(v[9], v[11]); CE(v[12], v[14]); CE(v[13], v[15]); CE(v[0], v[1]); CE(v[2], v[3]); CE(v[4], v[5]); CE(v[6], v[7]); CE(v[8], v[9]); CE(v[10], v[11]); CE(v[12], v[13]); CE(v[14], v[15]);
#undef CE
}
__device__ __forceinline__ void merge16_desc(float (&v)[16]) {
#define CE(a, b) do { const float hi_ = fmaxf(a, b), lo_ = fminf(a, b); a = hi_; b = lo_; } while (0)
    CE(v[0], v[8]); CE(v[1], v[9]); CE(v[2], v[10]); CE(v[3], v[11]); CE(v[4], v[12]); CE(v[5], v[13]); CE(v[6], v[14]); CE(v[7], v[15]); CE(v[0], v[4]); CE(v[1], v[5]); CE(v[2], v[6]); CE(v[3], v[7]); CE(v[8], v[12]); CE(v[9], v[13]); CE(v[10], v[14]); CE(v[11], v[15]); CE(v[0], v[2]); CE(v[1], v[3]); CE(v[4], v[6]); CE(v[5], v[7]); CE(v[8], v[10]); CE(v[9], v[11]); CE(v[12], v[14]); CE(v[13], v[15]); CE(v[0], v[1]); CE(v[2], v[3]); CE(v[4], v[5]); CE(v[6], v[7]); CE(v[8], v[9]); CE(v[10], v[11]); CE(v[12], v[13]); CE(v[14], v[15]);
#undef CE
}
__device__ __forceinline__ void p8_route(Frame& F) {
    using namespace rt;
    LAS unsigned char* const lds = F.lds;
    int tid_ = F.tid; asm volatile("" : "+v"(tid_));
    const int tid = tid_, lane = tid_ & 63, wave = F.wave, c32 = lane & 31, hi = lane >> 5;
    LAS unsigned char* const SK = lds;
    LAS float* const TOPS = (LAS float*)(lds + 65536 + wave * 8192);
    LAS int* const IDX = (LAS int*)(lds + 65536 + wave * 8192 + 4096);
    __syncthreads();
    for (int ch = tid; ch < 2 * 128 * 16; ch += NWAVES * 64) {
        const int row = ch >> 4, c = ch & 15; const GAS f32x4* src = (const GAS f32x4*)(F.subkeys + (size_t)row * 128 + c * 8);
        const f32x4 a = src[0], b = src[1]; v4u w; w.x = pk2(a.x, a.y); w.y = pk2(a.z, a.w); w.z = pk2(b.x, b.y); w.w = pk2(b.z, b.w);
        *(LAS v4u*)(SK + (row >> 7) * 32768 + RT_KSWZ(row & 127, c * 16)) = w;
    }
    __syncthreads();
    const int gw = F.vcu * NWAVES + wave, NGW = F.G * NWAVES;
    for (int item = gw; item < (M / 32) * PEER_H; item += NGW) {
        const int h = item % PEER_H, t0 = (item / PEER_H) * 32;
        f32x16 P0[4], P1[4];
#pragma unroll
        for (int p = 0; p < 2; ++p) {
            bf16x8 qf[8];
            { const bf16* qrow = F.QPB + (size_t)(t0 + c32) * D + h * PEER_QD + p * 128 + hi * 8;
#pragma unroll
              for (int d0 = 0; d0 < 8; ++d0) qf[d0] = *(const GAS bf16x8*)(qrow + d0 * 16); }
#pragma unroll
            for (int kg = 0; kg < 4; ++kg) {
                f32x16 acc = {};
#pragma unroll
                for (int d0 = 0; d0 < 8; ++d0) { const bf16x8 kf = *(const LAS bf16x8*)(SK + p * 32768 + RT_KSWZ(kg * 32 + c32, (d0 * 16 + hi * 8) * 2));
                    acc = __builtin_amdgcn_mfma_f32_32x32x16_bf16(kf, qf[d0], acc, 0, 0, 0); }
                if (p == 0) P0[kg] = acc; else P1[kg] = acc;
                __builtin_amdgcn_sched_barrier(0);
            }
        }
        float V[8][16];
#pragma unroll
        for (int kg = 0; kg < 4; ++kg)
#pragma unroll
            for (int r = 0; r < 16; ++r) {
                auto rr = __builtin_amdgcn_permlane32_swap(__float_as_uint(P0[kg][r]), __float_as_uint(P1[kg][r]), false, false);
                const int key0 = kg * 32 + (r & 3) + 8 * (r >> 2);
                V[2 * kg][r] = __uint_as_float((rr[0] & ~0x7Fu) | (unsigned)(127 - key0));
                V[2 * kg + 1][r] = __uint_as_float((rr[1] & ~0x7Fu) | (unsigned)(127 - (key0 + 4)));
            }
#pragma unroll
        for (int g = 0; g < 8; ++g) { sort16_desc(V[g]); __builtin_amdgcn_sched_barrier(0); }
#pragma unroll
        for (int g = 0; g < 8; g += 2) {
#pragma unroll
            for (int i = 0; i < 16; ++i) V[g][i] = fmaxf(V[g][i], V[g + 1][15 - i]);
            merge16_desc(V[g]); __builtin_amdgcn_sched_barrier(0); }
#pragma unroll
        for (int g = 0; g < 8; g += 4) {
#pragma unroll
            for (int i = 0; i < 16; ++i) V[g][i] = fmaxf(V[g][i], V[g + 2][15 - i]);
            merge16_desc(V[g]); __builtin_amdgcn_sched_barrier(0); }
#pragma unroll
        for (int i = 0; i < 16; ++i) V[0][i] = fmaxf(V[0][i], V[4][15 - i]);
        merge16_desc(V[0]);
#pragma unroll
        for (int k = 0; k < 16; ++k) TOPS[lane * 16 + k] = V[0][k];
        asm volatile("s_waitcnt lgkmcnt(0)" ::: "memory");
        float A[16], B[16];
#pragma unroll
        for (int k = 0; k < 16; ++k) { const float mine = TOPS[lane * 16 + k], oth = TOPS[(lane ^ 32) * 16 + k];
            IDX[(c32 * 2 + hi) * 16 + k] = 127 - (int)(__float_as_uint(mine) & 0x7Fu);
            A[k] = hi ? oth : mine; B[k] = hi ? mine : oth; }
        float Cn[4][16];
#pragma unroll
        for (int g = 0; g < 4; ++g)
#pragma unroll
            for (int i = 0; i < 16; ++i) Cn[g][i] = NEGV;
        { int n = 0;
#pragma unroll
          for (int i = 0; i < 16; ++i)
#pragma unroll
              for (int j = 0; j < 16; ++j) if ((i + 1) * (j + 1) <= 16) { Cn[n >> 4][n & 15] = __uint_as_float((__float_as_uint(A[i] + B[j]) & ~0xFFu) | (unsigned)(255 - (16 * i + j))); ++n; } }
#pragma unroll
        for (int g = 0; g < 4; ++g) { sort16_desc(Cn[g]); __builtin_amdgcn_sched_barrier(0); }
#pragma unroll
        for (int g = 0; g < 4; g += 2) {
#pragma unroll
            for (int i = 0; i < 16; ++i) Cn[g][i] = fmaxf(Cn[g][i], Cn[g + 1][15 - i]);
            merge16_desc(Cn[g]); }
#pragma unroll
        for (int i = 0; i < 16; ++i) Cn[0][i] = fmaxf(Cn[0][i], Cn[2][15 - i]);
        merge16_desc(Cn[0]);
        float W[16];
#pragma unroll
        for (int k = 0; k < 16; ++k) W[k] = Cn[0][k];
        asm volatile("s_waitcnt lgkmcnt(0)" ::: "memory");
        if (hi == 0) {
            float den = 0.f, e[16];
#pragma unroll
            for (int k = 0; k < 16; ++k) { e[k] = __builtin_amdgcn_exp2f((W[k] - W[0]) * LOG2E); den += e[k]; }
            const float inv = 1.0f / den;
            int* ido = F.IDS + (size_t)(t0 + c32) * PEER_SEL + h * PEER_K; float* gwo = F.GW + (size_t)(t0 + c32) * PEER_SEL + h * PEER_K;
#pragma unroll
            for (int k4 = 0; k4 < 4; ++k4) { int idv[4]; f32x4 gv;
#pragma unroll
                for (int k = 0; k < 4; ++k) { const int code = 255 - (int)(__float_as_uint(W[4 * k4 + k]) & 0xFFu);
                    idv[k] = IDX[(c32 * 2) * 16 + (code >> 4)] * PEER_NK + IDX[(c32 * 2 + 1) * 16 + (code & 15)]; gv[k] = e[4 * k4 + k] * inv; }
                *(GAS v4u*)(ido + 4 * k4) = (v4u){(unsigned)idv[0], (unsigned)idv[1], (unsigned)idv[2], (unsigned)idv[3]}; *(GAS f32x4*)(gwo + 4 * k4) = gv; }
        }
        asm volatile("s_waitcnt lgkmcnt(0)" ::: "memory");
    }
}

__device__ __forceinline__ f32x32v ld_row6(const unsigned char* tab, int id, int lane) {
    const GAS unsigned char* rp = (const GAS unsigned char*)tab + (size_t)id * ROW6 + 24 * lane;
    const v4u_a4 a = *(const GAS v4u_a4*)rp; const v2u_a4 b = *(const GAS v2u_a4*)(rp + 16);
    const u32x6v w = {a[0], a[1], a[2], a[3], b[0], b[1]};
    return __builtin_amdgcn_cvt_scalef32_pk32_f32_fp6(w, 1.0f);
}
constexpr int P9_GE = 4;
__device__ __forceinline__ float readlane_f(float v, int l) { return __int_as_float(__builtin_amdgcn_readlane(__float_as_int(v), l)); }
typedef int i32x8 __attribute__((ext_vector_type(8)));
__device__ __forceinline__ void p9_gather(Frame& F) {
    LAS unsigned char* const RB = F.lds + F.wave * 16384;
    LAS unsigned char* const XL8 = F.lds + P9X_OFF + F.wave * 2048;
    LAS float* const SC = (LAS float*)(F.lds + MISC_OFF + 192 + F.wave * 512);
    const int gw = F.vcu * NWAVES + F.wave, NGW = F.G * NWAVES, lane = F.lane;
    const int e16 = ((lane >> 5) & 1) * 8 + ((lane >> 4) & 1) * 4 + ((lane >> 3) & 1) * 2 + ((lane >> 2) & 1);
    const int srcl16 = ((lane >> 3) & 1) * 32 + ((lane >> 2) & 1) * 16 + ((lane >> 1) & 1) * 8 + (lane & 1) * 4;
    bool inter;
    { f32x16v t0, t1;
#pragma unroll
      for (int j = 0; j < 16; ++j) { t0[j] = 0.125f * j; t1[j] = j < 8 ? 2.0f + 0.25f * j : 4.0f + 0.5f * (j - 8); }
      const f32x32v y = __builtin_amdgcn_cvt_scalef32_pk32_f32_fp6(__builtin_amdgcn_cvt_scalef32_2xpk16_fp6_f32(t0, t1, 1.0f), 1.0f);
      inter = y[1] != 0.125f; }
    bool swap4;
    { const unsigned w = __builtin_amdgcn_cvt_scalef32_pk_fp4_f32(0u, 1.0f, 2.0f, 1.0f, 0); const f32x2 pr = __builtin_amdgcn_cvt_scalef32_pk_f32_fp4(w, 1.0f, 0); swap4 = pr.x != 1.0f; }
    LAS float* const LNG = (LAS float*)F.lds;
    __syncthreads();
    for (int i = F.tid; i < 2 * D / 4; i += NWAVES * 64) ((LAS f32x4*)LNG)[i] = i < D / 4 ? ((const GAS f32x4*)F.ln2_g)[i] : ((const GAS f32x4*)F.ln2_b)[i - D / 4];
    __syncthreads();
    if (gw >= M) return;
    int idA = F.IDS[(size_t)gw * PEER_SEL + lane], idB = F.IDS[(size_t)gw * PEER_SEL + 64 + lane];
    float gwA = F.GW[(size_t)gw * PEER_SEL + lane], gwB = F.GW[(size_t)gw * PEER_SEL + 64 + lane];
    f32x4 xf[8];
    { const GAS f32x4* xr = (const GAS f32x4*)(F.H1 + (size_t)gw * D + 32 * lane);
#pragma unroll
      for (int k = 0; k < 8; ++k) xf[k] = xr[k]; }
#pragma unroll 1
    for (int t = gw; t < M; t += NGW) {
        int idAn, idBn; float gwAn, gwBn; f32x4 xn[8];
        float cfA = 0.f, cfB = 0.f;
        {
            const int q4 = lane >> 4, r16 = lane & 15;
            { v4u w0, w1;
#pragma unroll
              for (int k = 0; k < 8; ++k) { const f32x4 a = xf[k]; const unsigned pk = pk4_fp8(a[0], a[1], a[2], a[3]); if (k < 4) w0[k] = pk; else w1[k - 4] = pk; }
              *(LAS v4u*)(XL8 + 32 * lane) = w0; *(LAS v4u*)(XL8 + 32 * lane + 16) = w1; }
            asm volatile("s_waitcnt lgkmcnt(0)" ::: "memory");
            i32x8 xB;
            { const v4u b0 = *(const LAS v4u*)(XL8 + 128 * r16 + 16 * q4), b1 = *(const LAS v4u*)(XL8 + 128 * r16 + 64 + 16 * q4);
              xB = (i32x8){(int)b0.x, (int)b0.y, (int)b0.z, (int)b0.w, (int)b1.x, (int)b1.y, (int)b1.z, (int)b1.w}; }
            const int pofs = 16 * (4 * r16 + q4);
            const bool ondiag = (r16 >> 2) == q4; const int dreg = r16 & 3;
#define P9_LDU(W_, IDV_, b4_) do { _Pragma("unroll") for (int e = 0; e < 4; ++e) \
        W_[e] = *(const GAS v4u*)(F.U8 + (size_t)__builtin_amdgcn_readlane(IDV_, (b4_) * 4 + e) * ROW4 + pofs); } while (0)
#define P9_DOT(W_, P_, o_) do { _Pragma("unroll") for (int e = 0; e < 4; ++e) { const i32x8 aa_ = {(int)W_[e].x, (int)W_[e].y, (int)W_[e].z, (int)W_[e].w, 0, 0, 0, 0}; \
        const f32x4 d_ = __builtin_amdgcn_mfma_scale_f32_16x16x128_f8f6f4(aa_, xB, (f32x4){0.f, 0.f, 0.f, 0.f}, 4  , 0  , 0, 0, 0, 0); \
        const float s_ = dreg == 0 ? d_[0] : (dreg == 1 ? d_[1] : (dreg == 2 ? d_[2] : d_[3])); P_[(o_) + e] = ondiag ? s_ : 0.f; } __builtin_amdgcn_sched_barrier(0); } while (0)
#pragma unroll 1
            for (int hf = 0; hf < 2; ++hf) {
                const int idv = hf ? idB : idA;
                float p[64]; v4u wA[4], wB[4];
                P9_LDU(wA, idv, 0);
#define P9_PAIR(b_) do { P9_LDU(wB, idv, (b_) + 1); __builtin_amdgcn_sched_barrier(0); P9_DOT(wA, p, 4 * (b_)); \
                         if ((b_) + 2 < 16) P9_LDU(wA, idv, (b_) + 2); __builtin_amdgcn_sched_barrier(0); P9_DOT(wB, p, 4 * (b_) + 4); } while (0)
                P9_PAIR(0); P9_PAIR(2); P9_PAIR(4); P9_PAIR(6); P9_PAIR(8); P9_PAIR(10); P9_PAIR(12); P9_PAIR(14);
#undef P9_PAIR
#define P9_RS(SRC_, DST_, n_, m_) do { const bool up_ = (lane & (m_)) != 0; _Pragma("unroll") for (int i = 0; i < (n_); ++i) { \
        const float snd = up_ ? SRC_[i] : SRC_[(n_) + i], kp = up_ ? SRC_[(n_) + i] : SRC_[i]; DST_[i] = kp + __shfl_xor(snd, (m_)); } } while (0)
                float q32[32], q16[16], q8[8], q4v[4], q2[2], q1[1];
                P9_RS(p, q32, 32, 32); P9_RS(q32, q16, 16, 16); P9_RS(q16, q8, 8, 8); P9_RS(q8, q4v, 4, 4); P9_RS(q4v, q2, 2, 2); P9_RS(q2, q1, 1, 1);
#undef P9_RS
                const float a = q1[0] * (1.0f / U6_SCALE);
                const float act = 0.5f * a * (1.0f + erff(a * 0.7071067811865476f));
                if (hf) cfB = gwB * act * (1.0f / V6_SCALE); else cfA = gwA * act * (1.0f / V6_SCALE);
            }
#undef P9_LDU
#undef P9_DOT
        }
        float os[32];
#pragma unroll
        for (int i = 0; i < 32; ++i) os[i] = 0.f;
        {
#define P9_LDV(W_, g_) do { const int iv_ = (g_) < 8 ? idA : idB; _Pragma("unroll") for (int e = 0; e < 8; ++e) \
        W_[e] = *((const GAS v4u*)(F.V8 + (size_t)__builtin_amdgcn_readlane(iv_, 8 * ((g_) & 7) + e) * ROW4) + lane); } while (0)
#define P9_ACC(W_, g_) do { const float cv_ = (g_) < 8 ? cfA : cfB; _Pragma("unroll") for (int e = 0; e < 8; ++e) { const float cf = readlane_f(cv_, 8 * ((g_) & 7) + e); const f32x2 cf2 = {cf, cf}; \
        _Pragma("unroll") for (int k = 0; k < 4; ++k) { const unsigned wk = W_[e][k]; \
            const f32x2 p0 = __builtin_amdgcn_cvt_scalef32_pk_f32_fp4(wk, 1.0f, 0), p1 = __builtin_amdgcn_cvt_scalef32_pk_f32_fp4(wk, 1.0f, 1), p2 = __builtin_amdgcn_cvt_scalef32_pk_f32_fp4(wk, 1.0f, 2), p3 = __builtin_amdgcn_cvt_scalef32_pk_f32_fp4(wk, 1.0f, 3); \
            os2[4 * k] = __builtin_elementwise_fma(p0, cf2, os2[4 * k]); os2[4 * k + 1] = __builtin_elementwise_fma(p1, cf2, os2[4 * k + 1]); \
            os2[4 * k + 2] = __builtin_elementwise_fma(p2, cf2, os2[4 * k + 2]); os2[4 * k + 3] = __builtin_elementwise_fma(p3, cf2, os2[4 * k + 3]); } \
        __builtin_amdgcn_sched_barrier(0); } } while (0)
            f32x2 os2[16];
#pragma unroll
            for (int i = 0; i < 16; ++i) os2[i] = (f32x2){0.f, 0.f};
            v4u vA[8], vB[8];
            P9_LDV(vA, 0);
            { const int tn = (t + NGW < M) ? t + NGW : t;
              idAn = F.IDS[(size_t)tn * PEER_SEL + lane]; idBn = F.IDS[(size_t)tn * PEER_SEL + 64 + lane]; gwAn = F.GW[(size_t)tn * PEER_SEL + lane]; gwBn = F.GW[(size_t)tn * PEER_SEL + 64 + lane];
              const GAS f32x4* xr = (const GAS f32x4*)(F.H1 + (size_t)tn * D + 32 * lane);
#pragma unroll
              for (int k = 0; k < 8; ++k) xn[k] = xr[k]; }
            __builtin_amdgcn_sched_barrier(0);
#pragma unroll 1
            for (int g = 0; g < 16; g += 2) {
                P9_LDV(vB, g + 1); __builtin_amdgcn_sched_barrier(0);
                P9_ACC(vA, g);
                if (g + 2 < 16) P9_LDV(vA, g + 2);
                __builtin_amdgcn_sched_barrier(0);
                P9_ACC(vB, g + 1);
            }
#pragma unroll
            for (int i = 0; i < 16; ++i) { os[2 * i] = os2[i].x; os[2 * i + 1] = os2[i].y; }
#undef P9_LDV
#undef P9_ACC
        }
        float on[32];
#pragma unroll
        for (int i = 0; i < 16; ++i) { on[2 * i] = swap4 ? os[2 * i + 1] : os[2 * i]; on[2 * i + 1] = swap4 ? os[2 * i] : os[2 * i + 1]; }
        float s = 0.f;
#pragma unroll
        for (int k = 0; k < 8; ++k) {
#pragma unroll
            for (int i = 0; i < 4; ++i) { on[4 * k + i] += xf[k][i] * DN_ALPHA; s += on[4 * k + i]; } }
        const float mean = wave_sum(s) * (1.f / D); float s2 = 0.f;
#pragma unroll
        for (int i = 0; i < 32; ++i) { on[i] -= mean; s2 += on[i] * on[i]; }
        const float rstd = 1.f / sqrtf(wave_sum(s2) * (1.f / D) + LN_EPS);
        GAS f32x4* orow = (GAS f32x4*)(F.out + (size_t)t * D + 32 * lane);
        const LAS f32x4* gr = (const LAS f32x4*)(LNG + 32 * lane); const LAS f32x4* br = (const LAS f32x4*)(LNG + D + 32 * lane);
#pragma unroll
        for (int k = 0; k < 8; ++k) { const f32x4 g0 = gr[k], b0 = br[k]; f32x4 y0;
#pragma unroll
            for (int i = 0; i < 4; ++i) y0[i] = on[4 * k + i] * rstd * g0[i] + b0[i];
            orow[k] = y0; }
        idA = idAn; idB = idBn; gwA = gwAn; gwB = gwBn;
#pragma unroll
        for (int k = 0; k < 8; ++k) xf[k] = xn[k];
    }
}

struct Args { const float* in[16]; float* out; unsigned char* ws; int ph_lo, ph_hi; };
__global__ void __launch_bounds__(NWAVES * 64, 2) mk_fwd(Args args) {
    extern __shared__ __attribute__((aligned(16))) unsigned char lds[];
    Frame F;
    F.lds = (LAS unsigned char*)lds;
    F.MISC = (volatile LAS unsigned*)(F.lds + MISC_OFF);
    F.tid = threadIdx.x; F.lane = F.tid & 63; F.wave = __builtin_amdgcn_readfirstlane(F.tid >> 6);
    F.G = gridDim.x; { const int bx = blockIdx.x; F.vcu = (F.G % 8 == 0) ? (bx % 8) * (F.G / 8) + bx / 8 : bx; }
    unsigned char* ws = args.ws;
    F.ctl = (gu32*)(ws + WS_CTL);
    F.x = args.in[0]; F.w_in = args.in[1]; F.w_gate = args.in[2]; F.b_gate = args.in[3]; F.w_bsb = args.in[4]; F.w_bmb = args.in[5]; F.w_out = args.in[6]; F.rel_bias = args.in[7];
    F.ln1_g = args.in[8]; F.ln1_b = args.in[9]; F.w_pq = args.in[10]; F.subkeys = args.in[11]; F.peer_u = args.in[12]; F.peer_v = args.in[13]; F.ln2_g = args.in[14]; F.ln2_b = args.in[15];
    F.out = args.out;
    F.KMEAN = (float*)(ws + WS_KMEAN); F.WIG = (bf16*)(ws + WS_WIG); F.WSB = (bf16*)(ws + WS_WSB); F.WMB = (bf16*)(ws + WS_WMB); F.WOUT = (bf16*)(ws + WS_WOUT); F.WPQ = (bf16*)(ws + WS_WPQ);
    F.IDS = (int*)(ws + WS_IDS); F.GW = (float*)(ws + WS_GW);
    F.QKV = (bf16*)(ws + WS_QKV); F.MIXED = (bf16*)(ws + WS_MIXED); F.GATE = (bf16*)(ws + WS_GATE); F.XB = (bf16*)(ws + WS_XB); F.OSB = (bf16*)(ws + WS_OSB); F.OMB = (bf16*)(ws + WS_OMB);
    F.X1B = (bf16*)(ws + WS_X1B); F.H1 = (float*)(ws + WS_H1); F.QP = (float*)(ws + WS_QP); F.QPB = (bf16*)(ws + WS_QP); F.U8 = ws + WS_U8; F.V8 = ws + WS_V8;
    for (int u = F.tid; u < (LDS_BYTES - LDSCTL_OFF) / 4; u += NWAVES * 64) ((LAS unsigned*)(F.lds + LDSCTL_OFF))[u] = 0u;
    __syncthreads();
    XcdBarrier bar; bar.bar = (unsigned*)(F.ctl + CW_BAR); bar.x = 0; bar.st = nullptr;
    if (N_LAUNCHES == 1) bar = xcd_barrier_post((unsigned*)(F.ctl + CW_BAR), F.MISC + 8);
    const int lo = args.ph_lo, hi = args.ph_hi;
#ifndef PHASE_MASK
#define PHASE_MASK 0x3ff
#endif
#define IN(k) (((PHASE_MASK >> (k)) & 1) && lo <= (k) && (k) < hi)
#define SEAM(k) do { if (IN(k) && IN((k) + 1)) xcd_barrier(bar); } while (0)
#ifndef PROBE_DUP
#define PROBE_DUP -1
#endif
#define REP(k) for (int rep_ = 0; rep_ < ((PROBE_DUP == (k)) ? 2 : 1); ++rep_)

    if (IN(0)) REP(0) { p0_prologue(F); SEAM(0); }
    if (IN(1)) REP(1) {
        pg8::Gemm g{F.XB, F.WIG, F.XB, F.WIG, M, N1, D / 2}; pg8::StaticOrder S; S.init(M, N1, F.G, (int)blockIdx.x);
        pg8::EpiQkvGate E{F.QKV, F.GATE, F.b_gate, 1.0f / W8_SCALE};
        pg8::gemm_phase<pg8::EpiQkvGate, pg8::StaticOrder, PG8_ALIGN, PG8_SP2, true>(F.lds + RING_OFF, g, S, E);
        SEAM(1);
    }
    if (IN(2)) REP(2) { p2_kmean(F); p2_sb(F); SEAM(2); }
    if (IN(3)) REP(3) { p3_moba(F); SEAM(3); }
    if (IN(4)) REP(4) {
        pg8::Gemm g{F.OSB, F.WSB, F.OMB, F.WMB, M, D, HW}; pg8::DualOrder S; S.init(M, D, F.G, (int)blockIdx.x);
        pg8::EpiBranch E{F.GATE, F.MIXED};
        pg8::gemm_phase<pg8::EpiBranch, pg8::DualOrder, PG8_ALIGN, PG8_SP2>(F.lds + RING_OFF, g, S, E);
        SEAM(4);
    }
    if (IN(5)) REP(5) {
        pg8::Gemm g{F.MIXED, F.WOUT, F.MIXED, F.WOUT, M, D, D / 2}; pg8::StaticOrder S; S.init(M, D, F.G, (int)blockIdx.x);
        pg8::EpiF32 E{F.H1, F.x, DN_ALPHA, D, 1.0f / W8_SCALE};
        pg8::gemm_phase<pg8::EpiF32, pg8::StaticOrder, PG8_ALIGN, PG8_SP2, true>(F.lds + RING_OFF, g, S, E);
        SEAM(5);
    }
    if (IN(6)) REP(6) { p6_ln1(F); p6_tables(F); SEAM(6); }
    if (IN(7)) REP(7) {
        pg8::Gemm g{F.X1B, F.WPQ, F.X1B, F.WPQ, M, D, D}; pg8::StaticOrder S; S.init(M, D, F.G, (int)blockIdx.x);
        pg8::EpiBf16 E{F.QPB, D};
        pg8::gemm_phase<pg8::EpiBf16, pg8::StaticOrder, PG8_ALIGN, PG8_SP2>(F.lds + RING_OFF, g, S, E);
        SEAM(7);
    }
    if (IN(8)) REP(8) { p8_route(F); SEAM(8); }
    if (IN(9)) REP(9) { p9_gather(F); }
#undef IN
#undef SEAM
}

extern "C" void kernel_launch(void* const* d_in, const int* in_sizes, int n_in, void* d_out, int out_size, void* d_ws, size_t ws_size, hipStream_t stream) {
    static int grid = 0;
    if (grid == 0) {
        if (n_in != 16 || in_sizes[0] != M * D || out_size != M * D || ws_size < WS_END) { fprintf(stderr, "kernel_launch: built for 16 inputs, x/out of %d floats, >= %zu bytes of workspace; got n_in %d, in0 %d, out %d, ws %zu; nothing launched\n", M * D, (size_t)WS_END, n_in, n_in > 0 ? in_sizes[0] : -1, out_size, ws_size); grid = -1; return; }
        int dev = 0, cus = 0, per_cu = 0;
        if (hipGetDevice(&dev) != hipSuccess || hipDeviceGetAttribute(&cus, hipDeviceAttributeMultiprocessorCount, dev) != hipSuccess) { fprintf(stderr, "kernel_launch: hipGetDevice / hipDeviceGetAttribute failed\n"); grid = -1; return; }
        if (hipFuncSetAttribute((const void*)mk_fwd, hipFuncAttributeMaxDynamicSharedMemorySize, LDS_BYTES) != hipSuccess) { fprintf(stderr, "kernel_launch: hipFuncSetAttribute failed\n"); grid = -1; return; }
        if (hipOccupancyMaxActiveBlocksPerMultiprocessor(&per_cu, (const void*)mk_fwd, NWAVES * 64, LDS_BYTES) != hipSuccess || per_cu < 1)
            fprintf(stderr, "kernel_launch: note: occupancy query reports %d workgroups per CU\n", per_cu);
        (void)hipGetLastError();
        grid = cus;
    }
    if (grid < 0) return;
    if (hipMemsetAsync((char*)d_ws + WS_CTL, 0, CTL_ZERO_BYTES, stream) != hipSuccess) { fprintf(stderr, "kernel_launch: hipMemsetAsync failed\n"); return; }
    Args a{};
    for (int i = 0; i < 16; ++i) a.in[i] = (const float*)d_in[i];
    a.out = (float*)d_out; a.ws = (unsigned char*)d_ws;
    for (int li = 0; li < N_LAUNCHES; ++li) {
        a.ph_lo = (N_LAUNCHES == 1) ? 0 : li; a.ph_hi = (N_LAUNCHES == 1) ? N_PHASES : li + 1;
        hipLaunchKernelGGL(mk_fwd, dim3(grid), dim3(NWAVES * 64), LDS_BYTES, stream, a);
        const hipError_t le = hipPeekAtLastError();
        if (le != hipSuccess) { fprintf(stderr, "kernel_launch: launch %d failed: %s\n", li, hipGetErrorName(le)); break; }
    }
#ifdef PROBE_PHASE
    a.ph_lo = PROBE_PHASE; a.ph_hi = PROBE_PHASE + 1;
    hipLaunchKernelGGL(mk_fwd, dim3(grid), dim3(NWAVES * 64), LDS_BYTES, stream, a);
#endif
}
```

```cpp
#include <hip/hip_runtime.h>
#include <cstdio>
#include <cstdint>
#include <cmath>
namespace pg8 {
#define PG8_LAS __attribute__((address_space(3)))
typedef unsigned short bf16_t;
typedef short bf16x8 __attribute__((ext_vector_type(8)));
typedef float f32x4 __attribute__((ext_vector_type(4)));
typedef unsigned u32x4 __attribute__((ext_vector_type(4)));
constexpr int BM = 256, BK = 64, HALF = 128, HTB = HALF * BK * 2  , STAGE_BYTES = 8 * HTB, NXCD = 8, WGM = 4;

__host__ __device__ __forceinline__ int lds_byte(int r, int c) { const int st = (r >> 4) * 2 + (c >> 5), rr = r & 15, cc = c & 31, ob = rr * 64 + cc * 2; return st * 1024 + (ob ^ (((ob >> 9) & 1) << 5)); }
__host__ __device__ __forceinline__ void stage_rc(int b, int& R, int& C) { const int st = b / 1024, sb = b % 1024, swz = sb ^ (((sb >> 9) & 1) << 5); R = (st >> 1) * 16 + swz / 64; C = (st & 1) * 32 + (swz % 64) / 2; }
__host__ __device__ __forceinline__ int perm32(int rho) { const int n = rho >> 4, i = rho & 15; return 8 * (i >> 2) + 4 * n + (i & 3); }

struct Unit { int pm, pn, src; };
struct Gemm { const bf16_t* A; const bf16_t* Bt; const bf16_t* A1; const bf16_t* Bt1; int M, N, K; };

struct StaticOrder {
    int nM, nN, nwg, G, c;
    __host__ __device__ void init(int M, int N, int G_, int c_) { nM = M / BM; nN = N / BM; nwg = nM * nN; G = G_; c = c_; }
    __host__ __device__ bool next(int i, Unit& u) const {
        const long L = (long)i * G + c; if (L >= nwg) return false;
        int wgid = (int)L; { const int q = nwg / NXCD, r = nwg % NXCD, xcd = wgid % NXCD, off = wgid / NXCD; wgid = (xcd < r ? xcd * (q + 1) : r * (q + 1) + (xcd - r) * q) + off; }
        const int nig = WGM * nN, gid = wgid / nig, fm = gid * WGM, gsz = (nM - fm) < WGM ? (nM - fm) : WGM;
        u.pm = fm + ((wgid % nig) % gsz); u.pn = (wgid % nig) / gsz; u.src = 0; return true;
    }
    __device__ __forceinline__ void a_ready(const Unit&) const {}
    __device__ __forceinline__ void done(const Unit&) const {}
};

__device__ __forceinline__ unsigned cvt_pk_bf16(float lo, float hi) { unsigned r; asm volatile("v_cvt_pk_bf16_f32 %0, %1, %2" : "=v"(r) : "v"(lo), "v"(hi)); return r; }
typedef float f32x2 __attribute__((ext_vector_type(2)));
__device__ __forceinline__ f32x2 gelu_pk(f32x2 v) {
    const f32x2 av = __builtin_elementwise_abs(v), d = av * 0.2316418882f + 1.0f;
    f32x2 t; t.x = __builtin_amdgcn_rcpf(d.x); t.y = __builtin_amdgcn_rcpf(d.y);
    f32x2 q = t * 0.5307027145f + (-0.7265760135f); q = q * t + 0.7107068705f; q = q * t + (-0.142248368f); q = q * t + 0.127414796f; q = q * t;
    const f32x2 s = (v * v) * (-0.72134752044f);
    f32x2 e; e.x = __builtin_amdgcn_exp2f(s.x); e.y = __builtin_amdgcn_exp2f(s.y);
    const f32x2 m = v * (q * e), r = v - m;
    f32x2 o; o.x = v.x < 0.f ? m.x : r.x; o.y = v.y < 0.f ? m.y : r.y; return o;
}

__device__ __forceinline__ float bf2f(unsigned short b) { return __uint_as_float((unsigned)b << 16); }
__device__ __forceinline__ float bflo(unsigned w) { return __uint_as_float(w << 16); }
__device__ __forceinline__ float bfhi(unsigned w) { return __uint_as_float(w & 0xffff0000u); }
__device__ __forceinline__ float sigmoid_fast(float v) { return __builtin_amdgcn_rcpf(1.0f + __builtin_amdgcn_exp2f(-1.4426950408889634f * v)); }

struct EpiQkvGate {
    static constexpr bool PERM = true, AFTER_DRAIN = false;
    bf16_t* QKV; bf16_t* GATE; const float* bgate; float oscale;
    __device__ __forceinline__ bool keep(const Unit&) const { return false; }
    __device__ __forceinline__ void operator()(f32x4 (&acc)[2][2][4][2], const Unit& u, int wr, int wc, int fr, int fq) const {
        const int row0 = u.pm * BM + wr * 64 + fr; const int colt = u.pn * BM;
        const bool isgate = colt >= 6144;
        bf16_t* base = isgate ? GATE : QKV + (size_t)(colt >> 7) * 16384 * 128; const int ldc = isgate ? 4096 : 128; const int cb = isgate ? (colt - 6144) >> 1 : 0;
        const size_t hstep = isgate ? (size_t)2048 : (size_t)16384 * 128;
        const int col0 = cb + wc * 32 + 8 * fq;
        f32x4 bv[2][2];
#pragma unroll
        for (int bj = 0; bj < 2; ++bj)
#pragma unroll
            for (int n = 0; n < 2; ++n) bv[bj][n] = isgate ? *(const f32x4*)(bgate + col0 + bj * 2048 + 4 * n) : (f32x4){0.f, 0.f, 0.f, 0.f};
#pragma unroll
        for (int ai = 0; ai < 2; ++ai)
#pragma unroll
            for (int m = 0; m < 4; ++m) { bf16_t* rowp = base + (size_t)(row0 + ai * HALF + m * 16) * ldc + col0;
                f32x4 v[2][2];
#pragma unroll
                for (int bj = 0; bj < 2; ++bj) { v[bj][0] = acc[ai][bj][m][0] * oscale + bv[bj][0]; v[bj][1] = acc[ai][bj][m][1] * oscale + bv[bj][1]; }
                if (isgate) {
#pragma unroll
                    for (int n = 0; n < 2; ++n)
#pragma unroll
                        for (int i = 0; i < 4; ++i) { const float gm = sigmoid_fast(v[1][n][i]); v[0][n][i] = sigmoid_fast(v[0][n][i]) * __builtin_amdgcn_rcpf(fmaxf(gm, 1e-30f)); v[1][n][i] = gm; } }
#pragma unroll
                for (int bj = 0; bj < 2; ++bj) { const f32x4 v0 = v[bj][0], v1 = v[bj][1];
                    u32x4 w; w.x = cvt_pk_bf16(v0[0], v0[1]); w.y = cvt_pk_bf16(v0[2], v0[3]); w.z = cvt_pk_bf16(v1[0], v1[1]); w.w = cvt_pk_bf16(v1[2], v1[3]);
                    *(u32x4*)(rowp + bj * hstep) = w; } }
    }
};

struct EpiBranch {
    static constexpr bool PERM = true, AFTER_DRAIN = false;
    const bf16_t* GATE; bf16_t* MIXED;
    __device__ __forceinline__ bool keep(const Unit& u) const { return u.src == 0; }
    __device__ __forceinline__ void operator()(f32x4 (&acc)[2][2][4][2], const Unit& u, int wr, int wc, int fr, int fq) const {
        const int row0 = u.pm * BM + wr * 64 + fr; const int col0 = u.pn * BM + wc * 32 + 8 * fq;
#pragma unroll
        for (int ai = 0; ai < 2; ++ai)
#pragma unroll
            for (int m = 0; m < 4; ++m) { const size_t r = (size_t)(row0 + ai * HALF + m * 16);
#pragma unroll
                for (int bj = 0; bj < 2; ++bj) {
                    const u32x4 gm = *(const u32x4*)(GATE + r * 4096 + (u.src == 0 ? 0 : 2048) + col0 + bj * HALF);
                    const float m_[8] = {bflo(gm.x), bfhi(gm.x), bflo(gm.y), bfhi(gm.y), bflo(gm.z), bfhi(gm.z), bflo(gm.w), bfhi(gm.w)};
                    if (u.src == 0) {
#pragma unroll
                        for (int i = 0; i < 4; ++i) { acc[ai][bj][m][0][i] *= m_[i]; acc[ai][bj][m][1][i] *= m_[4 + i]; }
                    } else {
                        f32x4 v0 = acc[ai][bj][m][0], v1 = acc[ai][bj][m][1];
#pragma unroll
                        for (int i = 0; i < 4; ++i) { v0[i] *= m_[i]; v1[i] *= m_[4 + i]; }
                        int w0 = 0, w1 = 0;
                        w0 = __builtin_amdgcn_cvt_pk_fp8_f32(fminf(fmaxf(v0[0], -448.f), 448.f), fminf(fmaxf(v0[1], -448.f), 448.f), w0, false); w0 = __builtin_amdgcn_cvt_pk_fp8_f32(fminf(fmaxf(v0[2], -448.f), 448.f), fminf(fmaxf(v0[3], -448.f), 448.f), w0, true);
                        w1 = __builtin_amdgcn_cvt_pk_fp8_f32(fminf(fmaxf(v1[0], -448.f), 448.f), fminf(fmaxf(v1[1], -448.f), 448.f), w1, false); w1 = __builtin_amdgcn_cvt_pk_fp8_f32(fminf(fmaxf(v1[2], -448.f), 448.f), fminf(fmaxf(v1[3], -448.f), 448.f), w1, true);
                        typedef unsigned pg8_u32x2 __attribute__((ext_vector_type(2)));
                        *(pg8_u32x2*)((unsigned char*)MIXED + r * 2048 + col0 + bj * HALF) = (pg8_u32x2){(unsigned)w0, (unsigned)w1}; } } }
    }
};

struct EpiF32 {
    static constexpr bool PERM = false, AFTER_DRAIN = false;
    float* out; const float* res; float alpha; int ldc; float oscale;
    __device__ __forceinline__ bool keep(const Unit&) const { return false; }
    __device__ __forceinline__ void operator()(f32x4 (&acc)[2][2][4][2], const Unit& u, int wr, int wc, int fr, int fq) const {
        const int row0 = u.pm * BM + wr * 64 + fr; const int col0 = u.pn * BM + wc * 32 + 4 * fq;
#pragma unroll
        for (int ai = 0; ai < 2; ++ai)
#pragma unroll
            for (int m = 0; m < 4; ++m) { const size_t off = (size_t)(row0 + ai * HALF + m * 16) * ldc + col0;
#pragma unroll
                for (int bj = 0; bj < 2; ++bj)
#pragma unroll
                    for (int n = 0; n < 2; ++n) { f32x4 v = acc[ai][bj][m][n] * oscale;
                        if (res) { const f32x4 x = *(const f32x4*)(res + off + bj * HALF + n * 16); v = v + x * alpha; }
                        *(f32x4*)(out + off + bj * HALF + n * 16) = v; } }
    }
};

struct EpiBf16 {
    static constexpr bool PERM = true, AFTER_DRAIN = false;
    bf16_t* O; int ldc;
    __device__ __forceinline__ bool keep(const Unit&) const { return false; }
    __device__ __forceinline__ void operator()(f32x4 (&acc)[2][2][4][2], const Unit& u, int wr, int wc, int fr, int fq) const {
        const int row0 = u.pm * BM + wr * 64 + fr; const int col0 = u.pn * BM + wc * 32 + 8 * fq;
#pragma unroll
        for (int ai = 0; ai < 2; ++ai)
#pragma unroll
            for (int m = 0; m < 4; ++m) { bf16_t* rowp = O + (size_t)(row0 + ai * HALF + m * 16) * ldc + col0;
#pragma unroll
                for (int bj = 0; bj < 2; ++bj) { const f32x4 v0 = acc[ai][bj][m][0], v1 = acc[ai][bj][m][1];
                    u32x4 w; w.x = cvt_pk_bf16(v0[0], v0[1]); w.y = cvt_pk_bf16(v0[2], v0[3]); w.z = cvt_pk_bf16(v1[0], v1[1]); w.w = cvt_pk_bf16(v1[2], v1[3]);
                    *(u32x4*)(rowp + bj * HALF) = w; } }
    }
};

struct DualOrder {
    StaticOrder so;
    __host__ __device__ void init(int M, int N, int G_, int c_) { so.init(M, N, G_, c_); }
    __host__ __device__ bool next(int i, Unit& u) const { if (!so.next(i >> 1, u)) return false; u.src = i & 1; return true; }
    __device__ __forceinline__ void a_ready(const Unit&) const {}
    __device__ __forceinline__ void done(const Unit&) const {}
};


typedef int pg8_i32x4 __attribute__((ext_vector_type(4)));
typedef int pg8_i32x8 __attribute__((ext_vector_type(8)));
template <class Epi, class Sched, bool ALIGN_EPI = false, bool SP2 = false, bool F8 = false>
__device__ __forceinline__ void gemm_phase(PG8_LAS unsigned char* lds, const Gemm g, const Sched& S, const Epi& E) {
    int tid_ = threadIdx.x; asm volatile("" : "+v"(tid_));
    const int tid = tid_, wid = __builtin_amdgcn_readfirstlane(tid >> 6), lane = tid & 63, wr = wid >> 2, wc = wid & 3, fr = lane & 15, fq = lane >> 4;
    const int K = g.K, nt = K / BK;
    unsigned voffA[2], voffB[2];
#pragma unroll
    for (int i = 0; i < 2; ++i) { int R, C; stage_rc(tid * 16 + i * 8192, R, C); const int Rb = Epi::PERM ? ((R & ~31) + perm32(R & 31)) : R;
        voffA[i] = (unsigned)(R * K + C) * 2u; voffB[i] = (unsigned)(Rb * K + C) * 2u; }
    const size_t kstep = (size_t)(BK * 2);
    const size_t hstep = (size_t)HALF * K * 2;
    const size_t tstep = 2 * hstep;
    const unsigned ldsw = (unsigned)wid * 1024u;
    const int aoff = lds_byte(wr * 64 + fr, fq * 8), boff = lds_byte(wc * 32 + fr, fq * 8);
#define PG8_SA(b, h) (((b) * 2 + (h)) * HTB)
#define PG8_SB(b, h) ((4 + (b) * 2 + (h)) * HTB)
#define PG8_STAGE(bufoff, gbase, voff) do { _Pragma("unroll") for (int _i = 0; _i < 2; ++_i) { unsigned vo_ = (voff)[_i]; asm volatile("" : "+v"(vo_));     \
        __builtin_amdgcn_global_load_lds((const unsigned*)((const char*)(gbase) + vo_), (PG8_LAS unsigned*)(lds + (bufoff) + ldsw + _i * 8192), 16, 0, 0); } } while (0)
#define PG8_LD8(dst8, addr) do { const pg8_i32x4 lo_ = *(const PG8_LAS pg8_i32x4*)(addr), hi_ = *(const PG8_LAS pg8_i32x4*)((addr) + 1024); dst8 = (pg8_i32x8){lo_.x, lo_.y, lo_.z, lo_.w, hi_.x, hi_.y, hi_.z, hi_.w}; } while (0)
#define PG8_LDA(dst, b, h) do { if constexpr (F8) { _Pragma("unroll") for (int m = 0; m < 4; ++m) PG8_LD8(dst##8[m], lds + PG8_SA(b, h) + aoff + m * 2048); } \
        else { _Pragma("unroll") for (int m = 0; m < 4; ++m) _Pragma("unroll") for (int k = 0; k < 2; ++k) dst[m][k] = *(const PG8_LAS bf16x8*)(lds + PG8_SA(b, h) + aoff + m * 2048 + k * 1024); } } while (0)
#define PG8_LDB(dst, b, h) do { if constexpr (F8) { _Pragma("unroll") for (int n = 0; n < 2; ++n) PG8_LD8(dst##8[n], lds + PG8_SB(b, h) + boff + n * 2048); } \
        else { _Pragma("unroll") for (int n = 0; n < 2; ++n) _Pragma("unroll") for (int k = 0; k < 2; ++k) dst[n][k] = *(const PG8_LAS bf16x8*)(lds + PG8_SB(b, h) + boff + n * 2048 + k * 1024); } } while (0)
#define PG8_MMA(ai, bj, At, Bt) do { __builtin_amdgcn_s_setprio(1); _Pragma("unroll") for (int m = 0; m < 4; ++m) _Pragma("unroll") for (int n = 0; n < 2; ++n) { \
        if constexpr (F8) acc[ai][bj][m][n] = __builtin_amdgcn_mfma_scale_f32_16x16x128_f8f6f4(Bt##8[n], At##8[m], acc[ai][bj][m][n], 0, 0, 0, 0, 0, 0); \
        else { _Pragma("unroll") for (int k = 0; k < 2; ++k) acc[ai][bj][m][n] = __builtin_amdgcn_mfma_f32_16x16x32_bf16(Bt[n][k], At[m][k], acc[ai][bj][m][n], 0, 0, 0); } } \
        __builtin_amdgcn_s_setprio(0); } while (0)
#define PG8_WAIT_V(n) asm volatile("s_waitcnt vmcnt(" #n ")" ::: "memory")
#define PG8_WAIT_L(n) asm volatile("s_waitcnt lgkmcnt(" #n ")" ::: "memory")
#define PG8_BAR __builtin_amdgcn_s_barrier()
#define PG8_SCHED __builtin_amdgcn_sched_barrier(0)
    Unit cur, nxt; int ui = 0;
    if (!S.next(0, cur)) return;
    f32x4 acc[2][2][4][2];
#pragma unroll
    for (int a = 0; a < 2; ++a)
#pragma unroll
        for (int b = 0; b < 2; ++b)
#pragma unroll
            for (int m = 0; m < 4; ++m)
#pragma unroll
                for (int n = 0; n < 2; ++n) acc[a][b][m][n] = (f32x4){0.f, 0.f, 0.f, 0.f};
    bf16x8 At[4][2], B0[2][2], B1[2][2]; pg8_i32x8 At8[4], B08[2], B18[2];
    const char* cA = (const char*)(cur.src ? g.A1 : g.A) + (size_t)cur.pm * tstep; const char* cB = (const char*)(cur.src ? g.Bt1 : g.Bt) + (size_t)cur.pn * tstep;
    S.a_ready(cur);
    if constexpr (SP2) {
        PG8_STAGE(PG8_SB(0, 0), cB, voffB); PG8_STAGE(PG8_SB(0, 1), cB + hstep, voffB); PG8_STAGE(PG8_SA(0, 0), cA, voffA); PG8_STAGE(PG8_SA(0, 1), cA + hstep, voffA);
        if (wr == 1) PG8_BAR;
        PG8_WAIT_V(2); PG8_BAR;
        PG8_STAGE(PG8_SB(1, 0), cB + kstep, voffB); PG8_STAGE(PG8_SA(1, 0), cA + kstep, voffA); PG8_STAGE(PG8_SB(1, 1), cB + hstep + kstep, voffB);
        PG8_WAIT_V(6); PG8_BAR;
    } else {
        PG8_STAGE(PG8_SB(0, 0), cB, voffB); PG8_STAGE(PG8_SA(0, 0), cA, voffA); PG8_STAGE(PG8_SB(0, 1), cB + hstep, voffB); PG8_STAGE(PG8_SA(0, 1), cA + hstep, voffA);
        if (wr == 1) PG8_BAR;
        PG8_WAIT_V(4); PG8_BAR;
        PG8_STAGE(PG8_SB(1, 0), cB + kstep, voffB); PG8_STAGE(PG8_SA(1, 0), cA + kstep, voffA); PG8_STAGE(PG8_SB(1, 1), cB + hstep + kstep, voffB);
        PG8_WAIT_V(6); PG8_BAR;
    }
    for (;;) {
        const bool has_next = S.next(ui + 1, nxt);
        const char* nA = has_next ? (const char*)(nxt.src ? g.A1 : g.A) + (size_t)nxt.pm * tstep : cA; const char* nB = has_next ? (const char*)(nxt.src ? g.Bt1 : g.Bt) + (size_t)nxt.pn * tstep : cB;
        for (int t = 0; t < nt; t += 2) {
            const bool last = (t == nt - 2);
            const char* a1 = cA + (size_t)(t + 1) * kstep;
            const char* a2 = last ? nA : cA + (size_t)(t + 2) * kstep; const char* b2 = last ? nB : cB + (size_t)(t + 2) * kstep;
            const char* a3 = a2 + kstep; const char* b3 = b2 + kstep;
            if (last && has_next) S.a_ready(nxt);
            if constexpr (SP2) {
            PG8_LDB(B0, 0, 0); PG8_LDB(B1, 0, 1); PG8_SCHED; PG8_LDA(At, 0, 0); PG8_STAGE(PG8_SA(1, 1), a1 + hstep, voffA);
            PG8_WAIT_V(8); PG8_WAIT_L(0); PG8_BAR; PG8_MMA(0, 0, At, B0); PG8_MMA(0, 1, At, B1); PG8_BAR; PG8_SCHED;
            PG8_LDA(At, 0, 1); PG8_STAGE(PG8_SB(0, 0), b2, voffB); PG8_STAGE(PG8_SB(0, 1), b2 + hstep, voffB); PG8_STAGE(PG8_SA(0, 0), a2, voffA);
            PG8_WAIT_V(8); PG8_WAIT_L(0); PG8_BAR; PG8_MMA(1, 0, At, B0); PG8_MMA(1, 1, At, B1); PG8_BAR; PG8_SCHED;
            PG8_LDB(B0, 1, 0); PG8_LDB(B1, 1, 1); PG8_SCHED; PG8_LDA(At, 1, 0); PG8_STAGE(PG8_SA(0, 1), a2 + hstep, voffA);
            PG8_WAIT_V(8); PG8_WAIT_L(0); PG8_BAR; PG8_MMA(0, 0, At, B0); PG8_MMA(0, 1, At, B1); PG8_BAR; PG8_SCHED;
            PG8_LDA(At, 1, 1); PG8_STAGE(PG8_SB(1, 0), b3, voffB); PG8_STAGE(PG8_SB(1, 1), b3 + hstep, voffB); PG8_STAGE(PG8_SA(1, 0), a3, voffA);
            PG8_WAIT_V(8); PG8_WAIT_L(0); PG8_BAR; PG8_MMA(1, 0, At, B0); PG8_MMA(1, 1, At, B1); PG8_BAR; PG8_SCHED;
            } else {
            PG8_LDB(B0, 0, 0); PG8_SCHED; PG8_LDA(At, 0, 0); PG8_STAGE(PG8_SA(1, 1), a1 + hstep, voffA);
            PG8_WAIT_L(8); PG8_BAR; PG8_WAIT_L(0); PG8_MMA(0, 0, At, B0); PG8_BAR; PG8_SCHED;
            PG8_LDB(B1, 0, 1); PG8_STAGE(PG8_SB(0, 0), b2, voffB);
            PG8_BAR; PG8_WAIT_L(0); PG8_MMA(0, 1, At, B1); PG8_BAR;
            PG8_LDA(At, 0, 1); PG8_STAGE(PG8_SA(0, 0), a2, voffA);
            PG8_BAR; PG8_WAIT_L(0); PG8_MMA(1, 0, At, B0); PG8_BAR; PG8_SCHED;
            PG8_STAGE(PG8_SB(0, 1), b2 + hstep, voffB);
            PG8_WAIT_V(6); PG8_BAR; PG8_MMA(1, 1, At, B1); PG8_BAR;
            PG8_LDB(B0, 1, 0); PG8_SCHED; PG8_LDA(At, 1, 0); PG8_STAGE(PG8_SA(0, 1), a2 + hstep, voffA);
            PG8_WAIT_L(8); PG8_BAR; PG8_WAIT_L(0); PG8_MMA(0, 0, At, B0); PG8_BAR; PG8_SCHED;
            PG8_LDB(B1, 1, 1); PG8_STAGE(PG8_SB(1, 0), b3, voffB);
            PG8_BAR; PG8_WAIT_L(0); PG8_MMA(0, 1, At, B1); PG8_BAR;
            PG8_LDA(At, 1, 1); PG8_STAGE(PG8_SA(1, 0), a3, voffA);
            PG8_BAR; PG8_WAIT_L(0); PG8_MMA(1, 0, At, B0); PG8_BAR; PG8_SCHED;
            PG8_STAGE(PG8_SB(1, 1), b3 + hstep, voffB);
            PG8_WAIT_V(6); PG8_BAR; PG8_MMA(1, 1, At, B1); PG8_BAR;
            }
        }
        if constexpr (ALIGN_EPI) { if (wr == 0) PG8_BAR; }
        if constexpr (!Epi::AFTER_DRAIN) { E(acc, cur, wr, wc, fr, fq); S.done(cur); }
        if (!has_next) break;
        if (!E.keep(cur)) {
#pragma unroll
        for (int a = 0; a < 2; ++a)
#pragma unroll
            for (int b = 0; b < 2; ++b)
#pragma unroll
                for (int m = 0; m < 4; ++m)
#pragma unroll
                    for (int n = 0; n < 2; ++n) acc[a][b][m][n] = (f32x4){0.f, 0.f, 0.f, 0.f};
        }
        cur = nxt; cA = nA; cB = nB; ++ui;
        if constexpr (ALIGN_EPI) { if (wr == 1) PG8_BAR; }
    }
    PG8_WAIT_V(0);
    if constexpr (!ALIGN_EPI) { if (wr == 0) PG8_BAR; }
    PG8_BAR;
    if constexpr (Epi::AFTER_DRAIN) { E.fused(acc, cur, wr, wc, fr, fq, lds, wid, lane); S.done(cur); }
#undef PG8_SA
#undef PG8_SB
#undef PG8_STAGE
#undef PG8_LDA
#undef PG8_LDB
#undef PG8_MMA
#undef PG8_WAIT_V
#undef PG8_WAIT_L
#undef PG8_BAR
#undef PG8_SCHED
}
}

#ifndef PG8_SP2
#define PG8_SP2 true
#endif
#ifndef PG8_ALIGN
#define PG8_ALIGN true
#endif
constexpr int NWAVES = 8;
constexpr int N_PHASES = 10;
#ifndef MK_N_LAUNCHES
#define MK_N_LAUNCHES 1
#endif
constexpr int N_LAUNCHES = MK_N_LAUNCHES;
static_assert(N_LAUNCHES == 1 || N_LAUNCHES == N_PHASES, "MK_N_LAUNCHES is 1 or N_PHASES");

constexpr int BATCH = 2, SEQ = 8192, D = 2048, M = BATCH * SEQ;
constexpr int NH = 8, HD = 128, HW = NH * HD;
constexpr int NQKV = 6 * HW, NGATE = 2 * D, N1 = NQKV + NGATE;
constexpr int S_QSB = 0, S_KSB = 1, S_VSB = 2, S_QMB = 3, S_KMB = 4, S_VMB = 5;
constexpr int MB_BLK = 256, MB_NB = SEQ / MB_BLK;
constexpr int PEER_H = 8, PEER_NK = 128, PEER_K = 16, PEER_QD = 256, PEER_SEL = PEER_H * PEER_K;
constexpr float LN_EPS = 1e-5f;
constexpr float DN_ALPHA = 1.189207115002721f;
constexpr float ATT_SCALE = 0.08838834764831845f;
constexpr float LOG2E = 1.4426950408889634f;
constexpr float SB_EXIT = 1e-12f;

constexpr size_t MiB = 1u << 20;
constexpr size_t WS_CTL = 0, CTL_ZERO_BYTES = 1 * MiB;
constexpr size_t WS_KMEAN = 1 * MiB;
constexpr size_t WS_WIG = 2 * MiB;
constexpr size_t WS_WSB = 42 * MiB, WS_WMB = 46 * MiB;
constexpr size_t WS_WOUT = 50 * MiB, WS_WPQ = 58 * MiB;
constexpr size_t WS_IDS = 66 * MiB, WS_GW = 74 * MiB;
constexpr size_t WS_QKV = 96 * MiB;
constexpr size_t WS_H1 = 96 * MiB;
constexpr size_t WS_MIXED = 224 * MiB;
constexpr size_t WS_GATE = 288 * MiB;
constexpr size_t WS_QP = 288 * MiB;
constexpr size_t WS_XB = 416 * MiB;
constexpr size_t WS_OSB = 416 * MiB, WS_OMB = 448 * MiB;
constexpr size_t WS_X1B = 416 * MiB;
constexpr size_t WS_U8 = 480 * MiB, WS_V8 = 496 * MiB;
constexpr size_t WS_STAT = 82 * MiB;
constexpr size_t WS_END = 512 * MiB;
constexpr int CW_BAR = 4096;

constexpr int RING_OFF = 0, RING_BYTES = 131072;
constexpr int LDSCTL_OFF = RING_BYTES, MISC_OFF = LDSCTL_OFF + 320;
constexpr int P9X_OFF = 147456;
constexpr int LDS_BYTES = 163840;
static_assert(MISC_OFF + 128 <= LDS_BYTES, "LDS map");

#define GAS __attribute__((address_space(1)))
#define LAS __attribute__((address_space(3)))
typedef unsigned short bf16;
typedef unsigned v4u __attribute__((ext_vector_type(4)));
typedef unsigned v2u __attribute__((ext_vector_type(2)));
typedef float f32x4 __attribute__((ext_vector_type(4)));
typedef float f32x2 __attribute__((ext_vector_type(2)));
typedef GAS unsigned gu32;
#define RLX_AGENT __ATOMIC_RELAXED, __HIP_MEMORY_SCOPE_AGENT
#define LDS_WAIT() asm volatile("s_waitcnt lgkmcnt(0)" ::: "memory")
#define VM_WAIT() asm volatile("s_waitcnt vmcnt(0)" ::: "memory")
__device__ __forceinline__ unsigned f2bf(float f) { unsigned u = __builtin_bit_cast(unsigned, f); return (u + 0x7fffu + ((u >> 16) & 1u)) >> 16; }
__device__ __forceinline__ unsigned pk2(float lo, float hi) { return f2bf(lo) | (f2bf(hi) << 16); }
__device__ __forceinline__ float bflo(unsigned w) { return __uint_as_float(w << 16); }
__device__ __forceinline__ float bfhi(unsigned w) { return __uint_as_float(w & 0xffff0000u); }

#define XB_TMO      128
#define XB_XCNT(j)  (256  + 64 * (j))
#define XB_XSUB(j)  (1280 + 64 * (j))
#define XB_XGEN(j)  (2304 + 64 * (j))
#define XB_TOP      3328
#define XB_TOPGEN   3392
#define XCD_BAR_WORDS 3456
#define XB_SPIN_CAP (1u << 18)

__device__ __forceinline__ unsigned xb_ld(unsigned* p)              { return __hip_atomic_load(p, __ATOMIC_RELAXED, __HIP_MEMORY_SCOPE_AGENT); }
__device__ __forceinline__ unsigned xb_add(unsigned* p, unsigned v) { return __hip_atomic_fetch_add(p, v, __ATOMIC_RELAXED, __HIP_MEMORY_SCOPE_AGENT); }
__device__ __forceinline__ unsigned xb_xcc_id() { return (unsigned)__builtin_amdgcn_s_getreg((3 << 11) | 20) & 0xFu; }
#define XB_SPIN(cond, bar) do { unsigned _sp = 0; while (cond) { __builtin_amdgcn_s_sleep(1); \
    if ((++_sp & 255u) == 0u) { if (xb_ld(&(bar)[XB_TMO])) break; if (_sp > XB_SPIN_CAP) { atomicAdd(&(bar)[XB_TMO], 1u); break; } } } } while (0)

struct XcdBarrier {
    unsigned* bar; unsigned x;
    volatile LAS unsigned* st;
};
__device__ __forceinline__ XcdBarrier xcd_barrier_post(unsigned* bar, volatile LAS unsigned* st) {
    XcdBarrier b; b.bar = bar; b.x = xb_xcc_id(); b.st = st;
    if (threadIdx.x == 0) (void)xb_add(&bar[XB_XCNT(b.x)], 1u);
    return b;
}
__device__ __forceinline__ void xcd_barrier_complete(unsigned* bar, unsigned x, unsigned& nloc, unsigned& nx) {
    const unsigned G = gridDim.x * gridDim.y * gridDim.z;
    unsigned sum, cnt, mine, sp = 0u;
    for (;;) {
        sum = 0u; cnt = 0u; mine = 0u;
#pragma unroll
        for (unsigned j = 0; j < 16; ++j) { const unsigned c = xb_ld(&bar[XB_XCNT(j)]); sum += c; cnt += (c > 0u) ? 1u : 0u; mine = (j == x) ? c : mine; }
        if (sum == G) break;
        __builtin_amdgcn_s_sleep(1);
        if ((++sp & 255u) == 0u) { if (xb_ld(&bar[XB_TMO])) break; if (sp > XB_SPIN_CAP) { atomicAdd(&bar[XB_TMO], 1u); break; } }
    }
    nloc = mine > 0u ? mine : 1u; nx = cnt > 0u ? cnt : 1u;
}
__device__ __forceinline__ void xcd_barrier(const XcdBarrier& b) {
    asm volatile("s_waitcnt vmcnt(0)" ::: "memory");
    __syncthreads();
    if (threadIdx.x == 0) {
        unsigned* bar = b.bar;
        __builtin_amdgcn_s_waitcnt(0);
        unsigned nloc = b.st[0], nx = b.st[1];
        if (nloc == 0u) { xcd_barrier_complete(bar, b.x, nloc, nx); b.st[0] = nloc; b.st[1] = nx; }
        const unsigned old = xb_add(&bar[XB_XSUB(b.x)], 1u);
        const unsigned gen = old / nloc;
        if (old + 1u == (gen + 1u) * nloc) {
            __builtin_amdgcn_fence(__ATOMIC_RELEASE, "agent");
            asm volatile("s_waitcnt vmcnt(0)" ::: "memory");
            const unsigned og = xb_add(&bar[XB_TOP], 1u);
            const unsigned tg = og / nx;
            if (og + 1u == (tg + 1u) * nx) xb_add(&bar[XB_TOPGEN], 1u);
            else XB_SPIN(xb_ld(&bar[XB_TOPGEN]) == tg, bar);
            __builtin_amdgcn_fence(__ATOMIC_ACQUIRE, "agent");
            xb_add(&bar[XB_XGEN(b.x)], 1u);
            asm volatile("s_waitcnt vmcnt(0)" ::: "memory");
        } else {
            XB_SPIN(xb_ld(&bar[XB_XGEN(b.x)]) == gen, bar);
            __builtin_amdgcn_fence(__ATOMIC_ACQUIRE, "agent");
            asm volatile("s_waitcnt vmcnt(0)" ::: "memory");
        }
    }
    __syncthreads();
}

struct Frame {
    LAS unsigned char* lds;
    volatile LAS unsigned* MISC;
    gu32* ctl;
    int tid, lane, wave;
    int vcu, G;
    const float *x, *w_in, *w_gate, *b_gate, *w_bsb, *w_bmb, *w_out, *rel_bias, *ln1_g, *ln1_b, *w_pq, *subkeys, *peer_u, *peer_v, *ln2_g, *ln2_b;
    float* out;
    float* KMEAN; bf16 *WIG, *WSB, *WMB, *WOUT, *WPQ; int* IDS; float* GW;
    bf16 *QKV, *MIXED, *GATE, *XB, *OSB, *OMB, *X1B, *QPB; float *H1, *QP; unsigned char *U8, *V8; float* STAT;
};

__device__ __forceinline__ float wave_sum(float v) {
#pragma unroll
    for (int o = 1; o < 64; o <<= 1) v += __shfl_xor(v, o);
    return v;
}
__device__ __forceinline__ float wave_max(float v) {
#pragma unroll
    for (int o = 1; o < 64; o <<= 1) v = fmaxf(v, __shfl_xor(v, o));
    return v;
}
__device__ __forceinline__ void wave_argmax(float& v, int& i) {
#pragma unroll
    for (int o = 1; o < 64; o <<= 1) { const float ov = __shfl_xor(v, o); const int oi = __shfl_xor(i, o); if (ov > v || (ov == v && oi < i)) { v = ov; i = oi; } }
}

__device__ __forceinline__ void p0_transpose_item(const float* W, int K, int N, bf16* WT, int row_off, LAS float* scr, int item, int lane) {
    const int nblk = N / 32, kb = item / nblk, nb = item % nblk, k0 = 64 * kb, n0 = 32 * nb;
    float tv[32];
#pragma unroll
    for (int i = 0; i < 32; ++i) { const int kk = 2 * i + (lane >> 5); tv[i] = W[(size_t)(k0 + kk) * N + n0 + (lane & 31)]; }
#pragma unroll
    for (int i = 0; i < 32; ++i) { const int kk = 2 * i + (lane >> 5); scr[kk * 33 + (lane & 31)] = tv[i]; }
    LDS_WAIT(); asm volatile("" ::: "memory");
    const int c = lane & 7;
#pragma unroll
    for (int j = 0; j < 4; ++j) { const int n = (lane >> 3) + 8 * j; const LAS float* s = scr + (8 * c) * 33 + n;
        v4u o; o.x = pk2(s[0 * 33], s[1 * 33]); o.y = pk2(s[2 * 33], s[3 * 33]); o.z = pk2(s[4 * 33], s[5 * 33]); o.w = pk2(s[6 * 33], s[7 * 33]);
        *(GAS v4u*)(WT + (size_t)(row_off + n0 + n) * K + k0 + 8 * c) = o; }
    LDS_WAIT(); asm volatile("" ::: "memory");
}
constexpr float W8_SCALE = 64.f;
__device__ __forceinline__ unsigned pk4_fp8(float a, float b, float c, float d) {
    int w = 0; w = __builtin_amdgcn_cvt_pk_fp8_f32(fminf(fmaxf(a, -448.f), 448.f), fminf(fmaxf(b, -448.f), 448.f), w, false);
    w = __builtin_amdgcn_cvt_pk_fp8_f32(fminf(fmaxf(c, -448.f), 448.f), fminf(fmaxf(d, -448.f), 448.f), w, true); return (unsigned)w; }
__device__ __forceinline__ void p0_transpose_item8(const float* W, int K, int N, unsigned char* WT, int row_off, LAS float* scr, int item, int lane) {
    const int nblk = N / 32, kb = item / nblk, nb = item % nblk, k0 = 64 * kb, n0 = 32 * nb;
    float tv[32];
#pragma unroll
    for (int i = 0; i < 32; ++i) { const int kk = 2 * i + (lane >> 5); tv[i] = W[(size_t)(k0 + kk) * N + n0 + (lane & 31)]; }
#pragma unroll
    for (int i = 0; i < 32; ++i) { const int kk = 2 * i + (lane >> 5); scr[kk * 33 + (lane & 31)] = tv[i] * W8_SCALE; }
    LDS_WAIT(); asm volatile("" ::: "memory");
    const int c = lane & 7;
#pragma unroll
    for (int j = 0; j < 4; ++j) { const int n = (lane >> 3) + 8 * j; const LAS float* s = scr + (8 * c) * 33 + n;
        v2u o; o.x = pk4_fp8(s[0 * 33], s[1 * 33], s[2 * 33], s[3 * 33]); o.y = pk4_fp8(s[4 * 33], s[5 * 33], s[6 * 33], s[7 * 33]);
        *(GAS v2u*)(WT + (size_t)(row_off + n0 + n) * K + k0 + 8 * c) = o; }
    LDS_WAIT(); asm volatile("" ::: "memory");
}
__device__ __forceinline__ void p0_prologue(Frame& F) {
    LAS float* scr = (LAS float*)(F.lds + RING_OFF + F.wave * 16384);
    const int gw = F.vcu * NWAVES + F.wave, NGW = F.G * NWAVES;
    constexpr int I_IN = (D / 64) * (NQKV / 32), I_G = (D / 64) * (NGATE / 32), I_B = (HW / 64) * (D / 32), I_O = (D / 64) * (D / 32);
    constexpr int NITEMS = I_IN + I_G + 2 * I_B + 2 * I_O;
    for (int it = gw; it < NITEMS; it += NGW) {
        int r = it;
        if (r < I_IN) { p0_transpose_item8(F.w_in, D, NQKV, (unsigned char*)F.WIG, 0, scr, r, F.lane); continue; } r -= I_IN;
        if (r < I_G) { const int n0 = 32 * (r % (NGATE / 32));
                       p0_transpose_item8(F.w_gate, D, NGATE, (unsigned char*)F.WIG, NQKV + 256 * ((n0 & 2047) >> 7) + 128 * (n0 >> 11) + (n0 & 127) - n0, scr, r, F.lane); continue; } r -= I_G;
        if (r < I_B) { p0_transpose_item(F.w_bsb, HW, D, F.WSB, 0, scr, r, F.lane); continue; } r -= I_B;
        if (r < I_B) { p0_transpose_item(F.w_bmb, HW, D, F.WMB, 0, scr, r, F.lane); continue; } r -= I_B;
        if (r < I_O) { p0_transpose_item8(F.w_out, D, D, (unsigned char*)F.WOUT, 0, scr, r, F.lane); continue; } r -= I_O;
        p0_transpose_item(F.w_pq, D, D, F.WPQ, 0, scr, r, F.lane);
    }
    for (int m = gw; m < M; m += NGW) {
        const GAS f32x4* xr = (const GAS f32x4*)(F.x + (size_t)m * D) + F.lane;
        GAS unsigned* o4 = (GAS unsigned*)((unsigned char*)F.XB + (size_t)m * D) + F.lane;
#pragma unroll
        for (int j = 0; j < 8; ++j) { const f32x4 v = xr[64 * j]; o4[64 * j] = pk4_fp8(v.x, v.y, v.z, v.w); }
    }
}

__device__ __forceinline__ void p2_kmean(Frame& F) {
    const int gw = F.vcu * NWAVES + F.wave, NGW = F.G * NWAVES, lane = F.lane;
    for (int it = gw; it < BATCH * NH * MB_NB * 4; it += NGW) {
        const int q = it & 3, n = (it >> 2) % MB_NB, bh = it / (4 * MB_NB), h = bh % NH, b = bh / NH;
        const GAS v4u* kp = (const GAS v4u*)(F.QKV + ((size_t)(S_KMB * NH + h) * M + b * SEQ + n * MB_BLK + q * 64 + (lane >> 4)) * HD) + (lane & 15);
        float a[8];
#pragma unroll
        for (int i = 0; i < 8; ++i) a[i] = 0.f;
#pragma unroll
        for (int r = 0; r < 16; ++r) { const v4u w = kp[(size_t)r * 4 * (HD / 8)];
            a[0] += bflo(w.x); a[1] += bfhi(w.x); a[2] += bflo(w.y); a[3] += bfhi(w.y); a[4] += bflo(w.z); a[5] += bfhi(w.z); a[6] += bflo(w.w); a[7] += bfhi(w.w); }
#pragma unroll
        for (int i = 0; i < 8; ++i) { a[i] += __shfl_xor(a[i], 16); a[i] += __shfl_xor(a[i], 32); }
        if (lane < 16) { GAS f32x4* o = (GAS f32x4*)(F.KMEAN + (size_t)it * HD + 8 * lane); o[0] = (f32x4){a[0], a[1], a[2], a[3]}; o[1] = (f32x4){a[4], a[5], a[6], a[7]}; }
    }
}

__device__ __forceinline__ int rel_bucket(int rel) {
    if (rel < 16) return rel;
    int b = 16;
    b += rel >= 21; b += rel >= 27; b += rel >= 35; b += rel >= 46; b += rel >= 59; b += rel >= 77; b += rel >= 99; b += rel >= 128;
    b += rel >= 166; b += rel >= 216; b += rel >= 280; b += rel >= 363; b += rel >= 470; b += rel >= 609; b += rel >= 790;
    return b;
}

constexpr float TAB_U_SCALE = 90.f, TAB_V_SCALE = 38.f;
__device__ __forceinline__ void tab_rows8(const Frame& F, int r0, int lane) {
    f32x4 va[4][2];
#pragma unroll 1
    for (int s8 = 0; s8 < 8; ++s8) { const int s4 = s8 & 3, e0r = (s8 >> 2) * 4;
#pragma unroll
        for (int e = 0; e < 4; ++e) { const int r = r0 + e0r + e; const bool isv = r >= PEER_NK * PEER_NK; const int rr = isv ? r - PEER_NK * PEER_NK : r;
            const GAS f32x4* src = (const GAS f32x4*)((isv ? F.peer_v : F.peer_u) + (size_t)rr * D + 512 * s4 + 8 * lane); va[e][0] = src[0]; va[e][1] = src[1]; }
#pragma unroll
        for (int e = 0; e < 4; ++e) { const int r = r0 + e0r + e; const bool isv = r >= PEER_NK * PEER_NK; const int rr = isv ? r - PEER_NK * PEER_NK : r;
            const float sc = isv ? TAB_V_SCALE : TAB_U_SCALE; unsigned w = 0u;
            const float e0 = fminf(fmaxf(va[e][0][0] * sc, -6.f), 6.f), e1 = fminf(fmaxf(va[e][0][1] * sc, -6.f), 6.f), e2 = fminf(fmaxf(va[e][0][2] * sc, -6.f), 6.f), e3 = fminf(fmaxf(va[e][0][3] * sc, -6.f), 6.f);
            const float e4 = fminf(fmaxf(va[e][1][0] * sc, -6.f), 6.f), e5 = fminf(fmaxf(va[e][1][1] * sc, -6.f), 6.f), e6 = fminf(fmaxf(va[e][1][2] * sc, -6.f), 6.f), e7 = fminf(fmaxf(va[e][1][3] * sc, -6.f), 6.f);
            w = __builtin_amdgcn_cvt_scalef32_pk_fp4_f32(w, e0, e1, 1.0f, 0); w = __builtin_amdgcn_cvt_scalef32_pk_fp4_f32(w, e2, e3, 1.0f, 1);
            w = __builtin_amdgcn_cvt_scalef32_pk_fp4_f32(w, e4, e5, 1.0f, 2); w = __builtin_amdgcn_cvt_scalef32_pk_fp4_f32(w, e6, e7, 1.0f, 3);
            *(GAS unsigned*)((isv ? F.V8 : F.U8) + (size_t)rr * (D / 2) + 256 * s4 + 4 * lane) = w; }
    }
}

namespace mb {
typedef short bf16x8 __attribute__((ext_vector_type(8)));
typedef short s16x4 __attribute__((ext_vector_type(4)));
typedef float f32x16 __attribute__((ext_vector_type(16)));
typedef unsigned u32x4 __attribute__((ext_vector_type(4)));
#define MB_KSWZ(row, colB) ((row) * 256 + ((colB) ^ (((row) & 7) << 4)))
__device__ __forceinline__ int v_st(int k, int c) { const int kk = (k & ~0xC) | ((k & 4) << 1) | ((k & 8) >> 1); return ((kk >> 3) * 4 + (c >> 5)) * 512 + ((kk & 7) * 32 + (c & 31)) * 2; }
__device__ __forceinline__ int v_rd_base(int lane) { return ((lane & 3) << 3) | (((lane >> 2) & 3) << 6) | (((lane >> 4) & 1) << 5) | (((lane >> 5) & 1) << 8); }
constexpr int v_rd_off(int d0, int ks, int half) { return d0 * 512 + ks * 4096 + half * 2048; }
__device__ __forceinline__ int crow(int r, int hi) { return (r & 3) + 8 * (r >> 2) + 4 * hi; }
__device__ __forceinline__ unsigned cvtpk(float lo, float hi) { unsigned r; asm volatile("v_cvt_pk_bf16_f32 %0, %1, %2" : "=v"(r) : "v"(lo), "v"(hi)); return r; }
constexpr int EXT = 131584;
constexpr int X_SEL = EXT, X_LISTS = EXT + 1024, X_CNT = EXT + 9216, X_UNITS = EXT + 9344, X_CTR = EXT + 9472, X_LUT = EXT + 9488, X_WS = EXT + 12688, X_END = EXT + 14736;
constexpr int LUTN = 800;
}
static_assert(mb::X_END <= LDS_BYTES, "MoBA LDS map");
constexpr size_t WS_PML = WS_IDS;

__device__ __forceinline__ void p3_moba(Frame& F) {
    using namespace mb;
    LAS unsigned char* const lds = F.lds;
    LAS float* const KM = (LAS float*)lds;
    LAS float* const GT = (LAS float*)(lds + 16384);
    LAS unsigned char* const SEL = lds + X_SEL;
    LAS unsigned char* const LISTS = lds + X_LISTS;
    LAS int* const CNT = (LAS int*)(lds + X_CNT);
    LAS unsigned short* const UNITS = (LAS unsigned short*)(lds + X_UNITS);
    LAS int* const CTR = (LAS int*)(lds + X_CTR);
    LAS float* const LUT = (LAS float*)(lds + X_LUT);
    LAS float* const WS = (LAS float*)(lds + X_WS) + F.wave * 64;
    LAS unsigned char* const Kl = lds + F.wave * 16384;
    LAS unsigned char* const Vl = Kl + 8192;
    int tid_ = F.tid; asm volatile("" : "+v"(tid_));
    const int tid = tid_, lane = tid_ & 63, wave = F.wave, r32 = lane & 31, hi = lane >> 5;
    float* const PO = F.out + (size_t)blockIdx.x * (256 * 4 * 128);
    float* const PML = (float*)((unsigned char*)F.ctl + WS_PML) + (size_t)blockIdx.x * (256 * 4 * 2);
    constexpr float C2 = ATT_SCALE * LOG2E;
    for (int item = F.vcu; item < BATCH * NH * MB_NB; item += F.G) {
        const int pass = item / (BATCH * NH * MB_NB / 2), ii = item % (BATCH * NH * MB_NB / 2);
        const int grp = ii / MB_NB, cix = ii % MB_NB;
        const int bh = (grp + 8 * pass) % (BATCH * NH), qb = pass ? (MB_NB - 1 - cix) : cix, h = bh % NH, b = bh / NH;
        const int nsel = qb < 3 ? qb : 3;
        const bf16* const Qb = F.QKV + ((size_t)(S_QMB * NH + h) * M + b * SEQ + qb * MB_BLK) * HD;
        const bf16* const Kh = F.QKV + ((size_t)(S_KMB * NH + h) * M + b * SEQ) * HD;
        const bf16* const Vh = F.QKV + ((size_t)(S_VMB * NH + h) * M + b * SEQ) * HD;
        __syncthreads();
        for (int i = tid; i < qb * HD; i += NWAVES * 64) { const float* kq = F.KMEAN + ((size_t)(bh * MB_NB + (i >> 7)) * 4) * HD + (i & 127);
            KM[i] = ((kq[0] + kq[HD]) + (kq[2 * HD] + kq[3 * HD])) * (1.0f / MB_BLK); }
        for (int i = tid; i < LUTN; i += NWAVES * 64) LUT[i] = F.rel_bias[h * 32 + rel_bucket(i)];
        if (tid < 32) CNT[tid] = 0;
        if (tid == 0) CTR[1] = 0;
        __syncthreads();
        if (qb > 0) {
            const int i = tid & 255, nh = tid >> 8; const int jmax = qb - nh * 16;
            float acc[16];
#pragma unroll
            for (int j = 0; j < 16; ++j) acc[j] = 0.f;
            const GAS v4u* qp = (const GAS v4u*)(Qb + (size_t)i * HD);
            for (int dc = 0; dc < 16; ++dc) {
                const v4u qw = qp[dc];
                const float q0 = bflo(qw.x), q1 = bfhi(qw.x), q2 = bflo(qw.y), q3 = bfhi(qw.y), q4 = bflo(qw.z), q5 = bfhi(qw.z), q6 = bflo(qw.w), q7 = bfhi(qw.w);
#pragma unroll
                for (int j = 0; j < 16; ++j) if (j < jmax) { const LAS f32x4* kp = (const LAS f32x4*)(KM + (nh * 16 + j) * HD + dc * 8); const f32x4 a = kp[0], c = kp[1];
                    acc[j] += q0 * a.x + q1 * a.y + q2 * a.z + q3 * a.w + q4 * c.x + q5 * c.y + q6 * c.z + q7 * c.w; }
            }
#pragma unroll
            for (int j = 0; j < 16; ++j) if (j < jmax) GT[i * 33 + nh * 16 + j] = acc[j];
        }
        __syncthreads();
        if (tid < 256) {
            unsigned chosen = 0u;
#pragma unroll
            for (int r = 0; r < 3; ++r) {
                int bi = 255;
                if (r < nsel) { float best = -3.0e38f; bi = 0;
                    for (int n = 0; n < qb; ++n) { const float v = GT[tid * 33 + n]; if (!((chosen >> n) & 1u) && v > best) { best = v; bi = n; } }
                    chosen |= 1u << bi;
                    const int pos = __hip_atomic_fetch_add(CNT + bi, 1, __ATOMIC_RELAXED, __HIP_MEMORY_SCOPE_WORKGROUP);
                    LISTS[bi * 256 + pos] = (unsigned char)tid; }
                SEL[tid * 4 + r] = (unsigned char)bi;
            }
        }
        __syncthreads();
        if (wave == 0) {
            const int nun = (lane < qb) ? ((CNT[lane & 31] + 31) >> 5) : 0; int pre = nun;
#pragma unroll
            for (int o = 1; o < 32; o <<= 1) { const int v = __shfl_up(pre, o); if ((lane & 31) >= o) pre += v; }
            const int tot = __shfl(pre, 31); pre -= nun;
            if (lane < 32) for (int k = 0; k < nun; ++k) UNITS[pre + k] = (unsigned short)(lane | (k << 5));
            if (lane < 8) UNITS[tot + lane] = (unsigned short)(0x8000 | (7 - lane));
            if (lane == 0) CTR[0] = tot + 8; }
        __syncthreads();
        const int NU = CTR[0];
        for (;;) {
            int u = 0; if (lane == 0) u = __hip_atomic_fetch_add(CTR + 1, 1, __ATOMIC_RELAXED, __HIP_MEMORY_SCOPE_WORKGROUP);
            u = __builtin_amdgcn_readfirstlane(u);
            if (u >= NU + 8) break;
            if (u >= NU) { tab_rows8(F, item * 64 + (u - NU) * 8, lane); continue; }
            const int code = UNITS[u]; const bool own = (code & 0x8000) != 0;
            const int n = own ? qb : (code & 31), ch = own ? (code & 7) : ((code >> 5) & 7);
            int qi, valid = 1, slot = 3;
            if (own) { qi = ch * 32 + r32; }
            else { const int c = CNT[n]; int e = ch * 32 + r32; if (e >= c) { e = c - 1; valid = 0; } qi = LISTS[n * 256 + e];
                   slot = (SEL[qi * 4] == n) ? 0 : ((SEL[qi * 4 + 1] == n) ? 1 : 2); }
            const int nst = own ? (ch + 1) : 8;
            const bool far = !own && (qb - n >= 5);
            const float cfar = LUT[LUTN - 1] * LOG2E;
            const int rel00 = (qb - n) * MB_BLK + qi - 4 * hi;
            bf16x8 qr[8];
            { const bf16* qrow = Qb + (size_t)qi * HD + hi * 8;
#pragma unroll
              for (int d0 = 0; d0 < 8; ++d0) qr[d0] = *(const GAS bf16x8*)(qrow + d0 * 16); }
            const bf16* const Kt = Kh + (size_t)(n * MB_BLK + (lane >> 4)) * HD + (lane & 15) * 8;
            const bf16* const Vt = Vh + (size_t)(n * MB_BLK + (lane >> 4)) * HD + (lane & 15) * 8;
            v4u sreg[8];
#define MB_LOADT(P_, j) do { _Pragma("unroll") for (int i_ = 0; i_ < 8; ++i_) sreg[i_] = *(const GAS v4u*)((P_) + (size_t)((j) * 32 + 4 * i_) * HD); } while (0)
            MB_LOADT(Kt, 0);
            f32x16 o[4] = {}; float m_reg = -1e30f, l_reg = 0.f;
            const int kw0 = MB_KSWZ(lane >> 4, (lane & 15) * 16);
            const int vb0 = (int)(uintptr_t)Vl + v_rd_base(lane);
            LAS const unsigned char* kb[4];
#pragma unroll
            for (int dd = 0; dd < 4; ++dd) kb[dd] = Kl + MB_KSWZ(r32, (dd * 16 + hi * 8) * 2);
            for (int j = 0; j < nst; ++j) {
#pragma unroll
                for (int i_ = 0; i_ < 8; ++i_) { const int row = (lane >> 4) + 4 * i_; *(LAS v4u*)(Kl + MB_KSWZ(row, (lane & 15) * 16)) = sreg[i_]; }
                asm volatile("s_waitcnt lgkmcnt(0)" ::: "memory");
                __builtin_amdgcn_sched_barrier(0);
                MB_LOADT(Vt, j);
                __builtin_amdgcn_sched_barrier(0);
                f32x16 p = {};
#pragma unroll
                for (int d0 = 0; d0 < 8; ++d0) { const bf16x8 kf = *(const LAS bf16x8*)(kb[d0 & 3] + (d0 >> 2) * 128); p = __builtin_amdgcn_mfma_f32_32x32x16_bf16(kf, qr[d0], p, 0, 0, 0); }
                if (far) {
#pragma unroll
                    for (int r = 0; r < 16; ++r) p[r] = fmaf(p[r], C2, cfar);
                } else {
                    const int relj = rel00 - 32 * j;
                    float bs[16];
#pragma unroll
                    for (int r = 0; r < 16; ++r) { const int rel = relj - ((r & 3) + 8 * (r >> 2)); bs[r] = LUT[rel < 0 ? 0 : (rel > LUTN - 1 ? LUTN - 1 : rel)]; }
                    asm volatile("s_waitcnt lgkmcnt(0)" : "+v"(bs[0]), "+v"(bs[1]), "+v"(bs[2]), "+v"(bs[3]), "+v"(bs[4]), "+v"(bs[5]), "+v"(bs[6]), "+v"(bs[7]),
                                 "+v"(bs[8]), "+v"(bs[9]), "+v"(bs[10]), "+v"(bs[11]), "+v"(bs[12]), "+v"(bs[13]), "+v"(bs[14]), "+v"(bs[15]) :: "memory");
#pragma unroll
                    for (int r = 0; r < 16; ++r) { const int rel = relj - ((r & 3) + 8 * (r >> 2)); const float v = fmaf(p[r], C2, bs[r] * LOG2E); p[r] = (rel >= 0) ? v : -__builtin_inff(); }
                }
                float pmax = fmaxf(fmaxf(fmaxf(fmaxf(p[0], p[1]), fmaxf(p[2], p[3])), fmaxf(fmaxf(p[4], p[5]), fmaxf(p[6], p[7]))),
                                   fmaxf(fmaxf(fmaxf(p[8], p[9]), fmaxf(p[10], p[11])), fmaxf(fmaxf(p[12], p[13]), fmaxf(p[14], p[15]))));
                { auto rr = __builtin_amdgcn_permlane32_swap(__float_as_uint(pmax), __float_as_uint(pmax), false, false); pmax = fmaxf(__uint_as_float(rr[0]), __uint_as_float(rr[1])); }
                float mn, alpha;
                if (__all(pmax - m_reg <= 8.0f)) { mn = m_reg; alpha = 1.f; }
                else { mn = fmaxf(m_reg, pmax); alpha = __builtin_amdgcn_exp2f(m_reg - mn); m_reg = mn; }
#pragma unroll
                for (int r = 0; r < 16; ++r) p[r] = __builtin_amdgcn_exp2f(p[r] - mn);
                float ps = (((p[0] + p[1]) + (p[2] + p[3])) + ((p[4] + p[5]) + (p[6] + p[7]))) + (((p[8] + p[9]) + (p[10] + p[11])) + ((p[12] + p[13]) + (p[14] + p[15])));
                { auto rr = __builtin_amdgcn_permlane32_swap(__float_as_uint(ps), __float_as_uint(ps), false, false); ps = __uint_as_float(rr[0]) + __uint_as_float(rr[1]); }
                l_reg = l_reg * alpha + ps;
                if (__any(alpha < 1.f)) {
                    if (hi == 0) WS[r32] = alpha;
                    asm volatile("s_waitcnt lgkmcnt(0)" ::: "memory");
#pragma unroll
                    for (int r = 0; r < 16; ++r) { const float a = WS[crow(r, hi)];
#pragma unroll
                        for (int d_ = 0; d_ < 4; ++d_) o[d_][r] *= a; }
                }
                bf16x8 pa0, pa1;
#define MB_PK4(P, B_, OUT) do { unsigned a0 = cvtpk(P[B_+0], P[B_+1]), a1 = cvtpk(P[B_+2], P[B_+3]); unsigned b0 = cvtpk(P[B_+4], P[B_+5]), b1 = cvtpk(P[B_+6], P[B_+7]); \
        auto r0 = __builtin_amdgcn_permlane32_swap(a0, b0, false, false); auto r1 = __builtin_amdgcn_permlane32_swap(a1, b1, false, false); \
        u32x4 w = {r0[0], r1[0], r0[1], r1[1]}; OUT = *reinterpret_cast<bf16x8*>(&w); } while (0)
                MB_PK4(p, 0, pa0); MB_PK4(p, 8, pa1);
                __builtin_amdgcn_sched_barrier(0);
#pragma unroll
                for (int i_ = 0; i_ < 8; ++i_) { const int row = (lane >> 4) + 4 * i_; *(LAS v4u*)(Vl + v_st(row, (lane & 15) * 8)) = sreg[i_]; }
                asm volatile("s_waitcnt lgkmcnt(0)" ::: "memory");
                __builtin_amdgcn_sched_barrier(0);
                if (j + 1 < nst) MB_LOADT(Kt, j + 1);
                __builtin_amdgcn_sched_barrier(0);
#define MB_TRRD(dst, off) asm volatile("ds_read_b64_tr_b16 %0, %1 offset:%2" : "=&v"(dst) : "v"(vb0), "i"(off) : "memory")
#define MB_PV(d0) do { s16x4 l0, l1, h0, h1; constexpr int b_ = v_rd_off(d0, 0, 0); \
        MB_TRRD(l0, b_); MB_TRRD(h0, b_ + 2048); MB_TRRD(l1, b_ + 4096); MB_TRRD(h1, b_ + 6144); \
        asm volatile("s_waitcnt lgkmcnt(0)" ::: "memory"); __builtin_amdgcn_sched_barrier(0); \
        o[d0] = __builtin_amdgcn_mfma_f32_32x32x16_bf16(pa0, (bf16x8){l0[0], l0[1], l0[2], l0[3], h0[0], h0[1], h0[2], h0[3]}, o[d0], 0, 0, 0); \
        o[d0] = __builtin_amdgcn_mfma_f32_32x32x16_bf16(pa1, (bf16x8){l1[0], l1[1], l1[2], l1[3], h1[0], h1[1], h1[2], h1[3]}, o[d0], 0, 0, 0); } while (0)
                { s16x4 vl[4][4];
#define MB_TR4(d0) do { constexpr int b_ = v_rd_off(d0, 0, 0); MB_TRRD(vl[d0][0], b_); MB_TRRD(vl[d0][1], b_ + 2048); MB_TRRD(vl[d0][2], b_ + 4096); MB_TRRD(vl[d0][3], b_ + 6144); } while (0)
                  MB_TR4(0); MB_TR4(1); MB_TR4(2); MB_TR4(3);
                  asm volatile("s_waitcnt lgkmcnt(0)" ::: "memory"); __builtin_amdgcn_sched_barrier(0);
#pragma unroll
                  for (int d0 = 0; d0 < 4; ++d0) {
                      o[d0] = __builtin_amdgcn_mfma_f32_32x32x16_bf16(pa0, (bf16x8){vl[d0][0][0], vl[d0][0][1], vl[d0][0][2], vl[d0][0][3], vl[d0][1][0], vl[d0][1][1], vl[d0][1][2], vl[d0][1][3]}, o[d0], 0, 0, 0);
                      o[d0] = __builtin_amdgcn_mfma_f32_32x32x16_bf16(pa1, (bf16x8){vl[d0][2][0], vl[d0][2][1], vl[d0][2][2], vl[d0][2][3], vl[d0][3][0], vl[d0][3][1], vl[d0][3][2], vl[d0][3][3]}, o[d0], 0, 0, 0); }
#undef MB_TR4
                }
            }
            if (hi == 0) ((LAS int*)WS)[32 + r32] = valid ? (qi * 4 + slot) : -1;
            asm volatile("s_waitcnt lgkmcnt(0)" ::: "memory");
#pragma unroll
            for (int r = 0; r < 16; ++r) { const int ri = ((LAS int*)WS)[32 + crow(r, hi)];
                if (ri >= 0) { float* dst = PO + (size_t)ri * 128 + r32;
#pragma unroll
                    for (int d_ = 0; d_ < 4; ++d_) dst[d_ * 32] = o[d_][r]; } }
            if (hi == 0 && valid) { float* ml = PML + (size_t)(qi * 4 + slot) * 2; ml[0] = m_reg; ml[1] = l_reg; }
            asm volatile("s_waitcnt lgkmcnt(0)" ::: "memory");
        }
        asm volatile("s_waitcnt vmcnt(0)" ::: "memory");
        __syncthreads();
        if (tid == 0) { __builtin_amdgcn_fence(__ATOMIC_ACQUIRE, "agent"); asm volatile("s_waitcnt vmcnt(0)" ::: "memory"); }
        __syncthreads();
        {
            const int qs = lane >> 4, dl = lane & 15;
#pragma unroll 2
            for (int it = 0; it < 8; ++it) {
                const int i = wave * 32 + 4 * it + qs;
                f32x2 ml[4]; f32x4 oa[4], ob[4];
#pragma unroll
                for (int s2 = 0; s2 < 4; ++s2) { const bool ok = (s2 == 3) || (s2 < nsel);
                    if (ok) { ml[s2] = *(const GAS f32x2*)(PML + (size_t)(i * 4 + s2) * 2); const GAS f32x4* src = (const GAS f32x4*)(PO + (size_t)(i * 4 + s2) * 128 + 8 * dl); oa[s2] = src[0]; ob[s2] = src[1]; }
                    else { ml[s2] = (f32x2){-3.0e38f, 0.f}; oa[s2] = (f32x4){0.f, 0.f, 0.f, 0.f}; ob[s2] = oa[s2]; } }
                const float mx = fmaxf(fmaxf(ml[0].x, ml[1].x), fmaxf(ml[2].x, ml[3].x));
                float L = 0.f; f32x4 ra = {0.f, 0.f, 0.f, 0.f}, rb = ra;
#pragma unroll
                for (int s2 = 0; s2 < 4; ++s2) { const float w = __builtin_amdgcn_exp2f(ml[s2].x - mx); L += w * ml[s2].y; ra = ra + oa[s2] * w; rb = rb + ob[s2] * w; }
                const float inv = 1.0f / L;
                v4u o; o.x = pk2(ra.x * inv, ra.y * inv); o.y = pk2(ra.z * inv, ra.w * inv); o.z = pk2(rb.x * inv, rb.y * inv); o.w = pk2(rb.z * inv, rb.w * inv);
                *(GAS v4u*)(F.OMB + (size_t)(b * SEQ + qb * MB_BLK + i) * HW + h * HD + 8 * dl) = o;
            }
        }
    }
#undef MB_LOADT
#undef MB_PK4
#undef MB_TRRD
#undef MB_PV
}


__device__ __forceinline__ void p2_sb(Frame& F) {
    using namespace mb;
    const int lane = F.lane, wave = F.wave, r32 = lane & 31, hi = lane >> 5;
    LAS unsigned char* const Kl = F.lds + wave * 16384;
    LAS unsigned char* const Vl = Kl + 8192;
    const int gw = F.vcu * NWAVES + wave, NGW = F.G * NWAVES;
    constexpr float C2 = ATT_SCALE * LOG2E;
    const int vb0 = (int)(uintptr_t)Vl + v_rd_base(lane);
    __syncthreads();
    for (int u = gw; u < BATCH * NH * (SEQ / 32); u += NGW) {
        const int bh = u / (SEQ / 32), qt = u % (SEQ / 32), h = bh % NH, b = bh / NH;
        const bf16* const Qb = F.QKV + ((size_t)(S_QSB * NH + h) * M + b * SEQ + qt * 32) * HD;
        const bf16* const Kt = F.QKV + ((size_t)(S_KSB * NH + h) * M + b * SEQ + (lane >> 4)) * HD + (lane & 15) * 8;
        const bf16* const Vt = F.QKV + ((size_t)(S_VSB * NH + h) * M + b * SEQ + (lane >> 4)) * HD + (lane & 15) * 8;
        bf16x8 qr[8];
        { const bf16* qrow = Qb + (size_t)r32 * HD + hi * 8;
#pragma unroll
          for (int d0 = 0; d0 < 8; ++d0) qr[d0] = *(const GAS bf16x8*)(qrow + d0 * 16); }
        v4u sreg[8];
#define SB_LOADT(P_, j) do { _Pragma("unroll") for (int i_ = 0; i_ < 8; ++i_) sreg[i_] = *(const GAS v4u*)((P_) + (size_t)((j) * 32 + 4 * i_) * HD); } while (0)
        SB_LOADT(Kt, qt);
        f32x16 o[4] = {}; float carry = 1.f;
        LAS const unsigned char* kb[4];
#pragma unroll
        for (int dd = 0; dd < 4; ++dd) kb[dd] = Kl + MB_KSWZ(r32, (dd * 16 + hi * 8) * 2);
        for (int j = qt; j >= 0; --j) {
#pragma unroll
            for (int i_ = 0; i_ < 8; ++i_) { const int row = (lane >> 4) + 4 * i_; *(LAS v4u*)(Kl + MB_KSWZ(row, (lane & 15) * 16)) = sreg[i_]; }
            asm volatile("s_waitcnt lgkmcnt(0)" ::: "memory");
            __builtin_amdgcn_sched_barrier(0);
            SB_LOADT(Vt, j);
            __builtin_amdgcn_sched_barrier(0);
            f32x16 p = {};
#pragma unroll
            for (int d0 = 0; d0 < 8; ++d0) { const bf16x8 kf = *(const LAS bf16x8*)(kb[d0 & 3] + (d0 >> 2) * 128); p = __builtin_amdgcn_mfma_f32_32x32x16_bf16(kf, qr[d0], p, 0, 0, 0); }
            float om[16];
            const bool diag = (j == qt);
#pragma unroll
            for (int r = 0; r < 16; ++r) { const float z = fminf(fmaxf(p[r] * C2, -100.f), 100.f); const float e = __builtin_amdgcn_exp2f(-z); float be = __builtin_amdgcn_rcpf(1.0f + e); float ob = e * be;
                if (diag && crow(r, hi) >= r32) { be = 0.f; ob = 1.f; }
                p[r] = be; om[r] = ob; }
            float gp[4], go[4];
#pragma unroll
            for (int g = 0; g < 4; ++g) gp[g] = (om[4 * g] * om[4 * g + 1]) * (om[4 * g + 2] * om[4 * g + 3]);
#pragma unroll
            for (int g = 0; g < 4; ++g) { auto rr = __builtin_amdgcn_permlane32_swap(__float_as_uint(gp[g]), __float_as_uint(gp[g]), false, false); go[g] = __uint_as_float(hi ? rr[0] : rr[1]); }
            float suf = carry;
#pragma unroll
            for (int g = 3; g >= 0; --g) {
                float e_ = hi ? suf : suf * go[g];
                p[4 * g + 3] *= e_; e_ *= om[4 * g + 3];
                p[4 * g + 2] *= e_; e_ *= om[4 * g + 2];
                p[4 * g + 1] *= e_; e_ *= om[4 * g + 1];
                p[4 * g] *= e_;
                suf *= gp[g] * go[g];
            }
            carry = suf;
            bf16x8 pa0, pa1;
#define SB_PK4(P, B_, OUT) do { unsigned a0 = cvtpk(P[B_+0], P[B_+1]), a1 = cvtpk(P[B_+2], P[B_+3]); unsigned b0 = cvtpk(P[B_+4], P[B_+5]), b1 = cvtpk(P[B_+6], P[B_+7]); \
        auto r0 = __builtin_amdgcn_permlane32_swap(a0, b0, false, false); auto r1 = __builtin_amdgcn_permlane32_swap(a1, b1, false, false); \
        u32x4 w = {r0[0], r1[0], r0[1], r1[1]}; OUT = *reinterpret_cast<bf16x8*>(&w); } while (0)
            SB_PK4(p, 0, pa0); SB_PK4(p, 8, pa1);
            __builtin_amdgcn_sched_barrier(0);
#pragma unroll
            for (int i_ = 0; i_ < 8; ++i_) { const int row = (lane >> 4) + 4 * i_; *(LAS v4u*)(Vl + v_st(row, (lane & 15) * 8)) = sreg[i_]; }
            asm volatile("s_waitcnt lgkmcnt(0)" ::: "memory");
            __builtin_amdgcn_sched_barrier(0);
            const bool more = (j > 0) && !__all(carry < SB_EXIT);
            if (more) SB_LOADT(Kt, j - 1);
            __builtin_amdgcn_sched_barrier(0);
#define SB_TRRD(dst, off) asm volatile("ds_read_b64_tr_b16 %0, %1 offset:%2" : "=&v"(dst) : "v"(vb0), "i"(off) : "memory")
#define SB_PV(d0) do { s16x4 l0, l1, h0, h1; constexpr int b_ = v_rd_off(d0, 0, 0); \
        SB_TRRD(l0, b_); SB_TRRD(h0, b_ + 2048); SB_TRRD(l1, b_ + 4096); SB_TRRD(h1, b_ + 6144); \
        asm volatile("s_waitcnt lgkmcnt(0)" ::: "memory"); __builtin_amdgcn_sched_barrier(0); \
        o[d0] = __builtin_amdgcn_mfma_f32_32x32x16_bf16(pa0, (bf16x8){l0[0], l0[1], l0[2], l0[3], h0[0], h0[1], h0[2], h0[3]}, o[d0], 0, 0, 0); \
        o[d0] = __builtin_amdgcn_mfma_f32_32x32x16_bf16(pa1, (bf16x8){l1[0], l1[1], l1[2], l1[3], h1[0], h1[1], h1[2], h1[3]}, o[d0], 0, 0, 0); } while (0)
            { s16x4 vl[4][4];
#define SB_TR4(d0) do { constexpr int b_ = v_rd_off(d0, 0, 0); SB_TRRD(vl[d0][0], b_); SB_TRRD(vl[d0][1], b_ + 2048); SB_TRRD(vl[d0][2], b_ + 4096); SB_TRRD(vl[d0][3], b_ + 6144); } while (0)
              SB_TR4(0); SB_TR4(1); SB_TR4(2); SB_TR4(3);
              asm volatile("s_waitcnt lgkmcnt(0)" ::: "memory"); __builtin_amdgcn_sched_barrier(0);
#pragma unroll
              for (int d0 = 0; d0 < 4; ++d0) {
                  o[d0] = __builtin_amdgcn_mfma_f32_32x32x16_bf16(pa0, (bf16x8){vl[d0][0][0], vl[d0][0][1], vl[d0][0][2], vl[d0][0][3], vl[d0][1][0], vl[d0][1][1], vl[d0][1][2], vl[d0][1][3]}, o[d0], 0, 0, 0);
                  o[d0] = __builtin_amdgcn_mfma_f32_32x32x16_bf16(pa1, (bf16x8){vl[d0][2][0], vl[d0][2][1], vl[d0][2][2], vl[d0][2][3], vl[d0][3][0], vl[d0][3][1], vl[d0][3][2], vl[d0][3][3]}, o[d0], 0, 0, 0); }
#undef SB_TR4
            }
            if (!more) break;
        }
        bf16* const Ob = F.OSB + (size_t)(b * SEQ + qt * 32) * HW + h * HD;
#pragma unroll
        for (int r = 0; r < 16; ++r) { const int orow = crow(r, hi);
#pragma unroll
            for (int d0 = 0; d0 < 4; ++d0) { const float v = o[d0][r]; const float vn = __shfl_xor(v, 1);
                if ((r32 & 1) == 0) *(GAS unsigned*)(Ob + (size_t)orow * HW + d0 * 32 + r32) = cvtpk(v, vn); } }
    }
#undef SB_LOADT
#undef SB_PK4
#undef SB_TRRD
#undef SB_PV
}

__device__ __forceinline__ void p6_ln1(Frame& F) {
    const int gw = F.vcu * NWAVES + F.wave, NGW = F.G * NWAVES;
    for (int m = gw; m < M; m += NGW) {
        GAS f32x4* xr = (GAS f32x4*)(F.H1 + (size_t)m * D) + F.lane;
        f32x4 v[8]; float s = 0.f;
#pragma unroll
        for (int j = 0; j < 8; ++j) { v[j] = xr[64 * j]; s += (v[j].x + v[j].y) + (v[j].z + v[j].w); }
        const float mean = wave_sum(s) * (1.f / D); float s2 = 0.f;
#pragma unroll
        for (int j = 0; j < 8; ++j) { v[j] = v[j] - mean; s2 += (v[j].x * v[j].x + v[j].y * v[j].y) + (v[j].z * v[j].z + v[j].w * v[j].w); }
        const float rstd = 1.f / sqrtf(wave_sum(s2) * (1.f / D) + LN_EPS);
        GAS v2u* o8 = (GAS v2u*)(F.X1B + (size_t)m * D) + F.lane;
#pragma unroll
        for (int j = 0; j < 8; ++j) { const f32x4 gg = *((const GAS f32x4*)F.ln1_g + F.lane + 64 * j), bb = *((const GAS f32x4*)F.ln1_b + F.lane + 64 * j);
            const f32x4 y = v[j] * rstd * gg + bb; v2u w; w.x = pk2(y.x, y.y); w.y = pk2(y.z, y.w); o8[64 * j] = w; }
        if (F.lane == 0) *(GAS f32x2*)(F.STAT + 2 * (size_t)m) = (f32x2){mean, rstd};
    }
}

typedef float f32x16v __attribute__((ext_vector_type(16)));
typedef float f32x32v __attribute__((ext_vector_type(32)));
typedef unsigned u32x6v __attribute__((ext_vector_type(6)));
typedef unsigned v4u_a4 __attribute__((ext_vector_type(4), aligned(4)));
typedef unsigned v2u_a4 __attribute__((ext_vector_type(2), aligned(4)));
constexpr float U6_SCALE = 90.f, V6_SCALE = 38.f;
constexpr int ROW6 = D * 6 / 8;
constexpr int ROW4 = D / 2;
__device__ __forceinline__ void p6_tables(Frame& F) {
    const size_t gt = (size_t)F.vcu * (NWAVES * 64) + F.tid, NGT = (size_t)F.G * (NWAVES * 64);
    constexpr size_t NCH = (size_t)PEER_NK * PEER_NK * D / 32;
    for (size_t c = gt; c < 2 * NCH; c += NGT) {
        const bool isv = c >= NCH; const size_t cc = isv ? c - NCH : c;
        const GAS f32x4* src = (const GAS f32x4*)((isv ? F.peer_v : F.peer_u) + cc * 32);
        {
            v4u o;
#pragma unroll
            for (int k = 0; k < 4; ++k) { const f32x4 va = src[2 * k], vb = src[2 * k + 1]; unsigned w = 0u;
                const float sc = isv ? V6_SCALE : U6_SCALE;
                const float e0 = fminf(fmaxf(va[0] * sc, -6.f), 6.f), e1 = fminf(fmaxf(va[1] * sc, -6.f), 6.f), e2 = fminf(fmaxf(va[2] * sc, -6.f), 6.f), e3 = fminf(fmaxf(va[3] * sc, -6.f), 6.f);
                const float e4 = fminf(fmaxf(vb[0] * sc, -6.f), 6.f), e5 = fminf(fmaxf(vb[1] * sc, -6.f), 6.f), e6 = fminf(fmaxf(vb[2] * sc, -6.f), 6.f), e7 = fminf(fmaxf(vb[3] * sc, -6.f), 6.f);
                w = __builtin_amdgcn_cvt_scalef32_pk_fp4_f32(w, e0, e1, 1.0f, 0); w = __builtin_amdgcn_cvt_scalef32_pk_fp4_f32(w, e2, e3, 1.0f, 1);
                w = __builtin_amdgcn_cvt_scalef32_pk_fp4_f32(w, e4, e5, 1.0f, 2); w = __builtin_amdgcn_cvt_scalef32_pk_fp4_f32(w, e6, e7, 1.0f, 3);
                o[k] = w; }
            *(GAS v4u*)((isv ? F.V8 : F.U8) + cc * 16) = o;
        }
    }
}


namespace rt {
typedef short bf16x8 __attribute__((ext_vector_type(8)));
typedef float f32x16 __attribute__((ext_vector_type(16)));
#define RT_KSWZ(row, colB) ((row) * 256 + ((colB) ^ (((row) & 7) << 4)))
constexpr float NEGV = -3.0e38f;
}
__device__ __forceinline__ void sort16_desc(float (&v)[16]) {
#define CE(a, b) do { const float hi_ = fmaxf(a, b), lo_ = fminf(a, b); a = hi_; b = lo_; } while (0)
    CE(v[0], v[1]); CE(v[3], v[2]); CE(v[4], v[5]); CE(v[7], v[6]); CE(v[8], v[9]); CE(v[11], v[10]); CE(v[12], v[13]); CE(v[15], v[14]); CE(v[0], v[2]); CE(v[1], v[3]); CE(v[6], v[4]); CE(v[7], v[5]); CE(v[8], v[10]); CE(v[9], v[11]); CE(v[14], v[12]); CE(v[15], v[13]); CE(v[0], v[1]); CE(v[2], v[3]); CE(v[5], v[4]); CE(v[7], v[6]); CE(v[8], v[9]); CE(v[10], v[11]); CE(v[13], v[12]); CE(v[15], v[14]); CE(v[0], v[4]); CE(v[1], v[5]); CE(v[2], v[6]); CE(v[3], v[7]); CE(v[12], v[8]); CE(v[13], v[9]); CE(v[14], v[10]); CE(v[15], v[11]); CE(v[0], v[2]); CE(v[1], v[3]); CE(v[4], v[6]); CE(v[5], v[7]); CE(v[10], v[8]); CE(v[11], v[9]); CE(v[14], v[12]); CE(v[15], v[13]); CE(v[0], v[1]); CE(v[2], v[3]); CE(v[4], v[5]); CE(v[6], v[7]); CE(v[9], v[8]); CE(v[11], v[10]); CE(v[13], v[12]); CE(v[15], v[14]); CE(v[0], v[8]); CE(v[1], v[9]); CE(v[2], v[10]); CE(v[3], v[11]); CE(v[4], v[12]); CE(v[5], v[13]); CE(v[6], v[14]); CE(v[7], v[15]); CE(v[0], v[4]); CE(v[1], v[5]); CE(v[2], v[6]); CE(v[3], v[7]); CE(v[8], v[12]); CE(v[9], v[13]); CE(v[10], v[14]); CE(v[11], v[15]); CE(v[0], v[2]); CE(v[1], v[3]); CE(v[4], v[6]); CE(v[5], v[7]); CE(v[8], v[10]); CE(v[9], v[11]); CE(v[12], v[14]); CE(v[13], v[15]); CE(v[0], v[1]); CE(v[2], v[3]); CE(v[4], v[5]); CE(v[6], v[7]); CE(v[8], v[9]); CE(v[10], v[11]); CE(v[12], v[13]); CE(v[14], v[15]);
#undef CE
}
__device__ __forceinline__ void merge16_desc(float (&v)[16]) {
#define CE(a, b) do { const float hi_ = fmaxf(a, b), lo_ = fminf(a, b); a = hi_; b = lo_; } while (0)
    CE(v[0], v[8]); CE(v[1], v[9]); CE(v[2], v[10]); CE(v[3], v[11]); CE(v[4], v[12]); CE(v[5], v[13]); CE(v[6], v[14]); CE(v[7], v[15]); CE(v[0], v[4]); CE(v[1], v[5]); CE(v[2], v[6]); CE(v[3], v[7]); CE(v[8], v[12]); CE(v[9], v[13]); CE(v[10], v[14]); CE(v[11], v[15]); CE(v[0], v[2]); CE(v[1], v[3]); CE(v[4], v[6]); CE(v[5], v[7]); CE(v[8], v[10]); CE(v[9], v[11]); CE(v[12], v[14]); CE(v[13], v[15]); CE(v[0], v[1]); CE(v[2], v[3]); CE(v[4], v[5]); CE(v[6], v[7]); CE(v[8], v[9]); CE(v[10], v[11]); CE(v[12], v[13]); CE(v[14], v[15]);
#undef CE
}
__device__ __forceinline__ void p8_route(Frame& F) {
    using namespace rt;
    LAS unsigned char* const lds = F.lds;
    int tid_ = F.tid; asm volatile("" : "+v"(tid_));
    const int tid = tid_, lane = tid_ & 63, wave = F.wave, c32 = lane & 31, hi = lane >> 5;
    LAS unsigned char* const SK = lds;
    LAS float* const TOPS = (LAS float*)(lds + 65536 + wave * 8192);
    LAS int* const IDX = (LAS int*)(lds + 65536 + wave * 8192 + 4096);
    __syncthreads();
    for (int ch = tid; ch < 2 * 128 * 16; ch += NWAVES * 64) {
        const int row = ch >> 4, c = ch & 15; const GAS f32x4* src = (const GAS f32x4*)(F.subkeys + (size_t)row * 128 + c * 8);
        const f32x4 a = src[0], b = src[1]; v4u w; w.x = pk2(a.x, a.y); w.y = pk2(a.z, a.w); w.z = pk2(b.x, b.y); w.w = pk2(b.z, b.w);
        *(LAS v4u*)(SK + (row >> 7) * 32768 + RT_KSWZ(row & 127, c * 16)) = w;
    }
    __syncthreads();
    const int gw = F.vcu * NWAVES + wave, NGW = F.G * NWAVES;
    for (int item = gw; item < (M / 32) * PEER_H; item += NGW) {
        const int h = item % PEER_H, t0 = (item / PEER_H) * 32;
        f32x16 P0[4], P1[4];
#pragma unroll
        for (int p = 0; p < 2; ++p) {
            bf16x8 qf[8];
            { const bf16* qrow = F.QPB + (size_t)(t0 + c32) * D + h * PEER_QD + p * 128 + hi * 8;
#pragma unroll
              for (int d0 = 0; d0 < 8; ++d0) qf[d0] = *(const GAS bf16x8*)(qrow + d0 * 16); }
#pragma unroll
            for (int kg = 0; kg < 4; ++kg) {
                f32x16 acc = {};
#pragma unroll
                for (int d0 = 0; d0 < 8; ++d0) { const bf16x8 kf = *(const LAS bf16x8*)(SK + p * 32768 + RT_KSWZ(kg * 32 + c32, (d0 * 16 + hi * 8) * 2));
                    acc = __builtin_amdgcn_mfma_f32_32x32x16_bf16(kf, qf[d0], acc, 0, 0, 0); }
                if (p == 0) P0[kg] = acc; else P1[kg] = acc;
                __builtin_amdgcn_sched_barrier(0);
            }
        }
        float V[8][16];
#pragma unroll
        for (int kg = 0; kg < 4; ++kg)
#pragma unroll
            for (int r = 0; r < 16; ++r) {
                auto rr = __builtin_amdgcn_permlane32_swap(__float_as_uint(P0[kg][r]), __float_as_uint(P1[kg][r]), false, false);
                const int key0 = kg * 32 + (r & 3) + 8 * (r >> 2);
                V[2 * kg][r] = __uint_as_float((rr[0] & ~0x7Fu) | (unsigned)(127 - key0));
                V[2 * kg + 1][r] = __uint_as_float((rr[1] & ~0x7Fu) | (unsigned)(127 - (key0 + 4)));
            }
#pragma unroll
        for (int g = 0; g < 8; ++g) { sort16_desc(V[g]); __builtin_amdgcn_sched_barrier(0); }
#pragma unroll
        for (int g = 0; g < 8; g += 2) {
#pragma unroll
            for (int i = 0; i < 16; ++i) V[g][i] = fmaxf(V[g][i], V[g + 1][15 - i]);
            merge16_desc(V[g]); __builtin_amdgcn_sched_barrier(0); }
#pragma unroll
        for (int g = 0; g < 8; g += 4) {
#pragma unroll
            for (int i = 0; i < 16; ++i) V[g][i] = fmaxf(V[g][i], V[g + 2][15 - i]);
            merge16_desc(V[g]); __builtin_amdgcn_sched_barrier(0); }
#pragma unroll
        for (int i = 0; i < 16; ++i) V[0][i] = fmaxf(V[0][i], V[4][15 - i]);
        merge16_desc(V[0]);
#pragma unroll
        for (int k = 0; k < 16; ++k) TOPS[lane * 16 + k] = V[0][k];
        asm volatile("s_waitcnt lgkmcnt(0)" ::: "memory");
        float A[16], B[16];
#pragma unroll
        for (int k = 0; k < 16; ++k) { const float mine = TOPS[lane * 16 + k], oth = TOPS[(lane ^ 32) * 16 + k];
            IDX[(c32 * 2 + hi) * 16 + k] = 127 - (int)(__float_as_uint(mine) & 0x7Fu);
            A[k] = hi ? oth : mine; B[k] = hi ? mine : oth; }
        float Cn[4][16];
#pragma unroll
        for (int g = 0; g < 4; ++g)
#pragma unroll
            for (int i = 0; i < 16; ++i) Cn[g][i] = NEGV;
        { int n = 0;
#pragma unroll
          for (int i = 0; i < 16; ++i)
#pragma unroll
              for (int j = 0; j < 16; ++j) if ((i + 1) * (j + 1) <= 16) { Cn[n >> 4][n & 15] = __uint_as_float((__float_as_uint(A[i] + B[j]) & ~0xFFu) | (unsigned)(255 - (16 * i + j))); ++n; } }
#pragma unroll
        for (int g = 0; g < 4; ++g) { sort16_desc(Cn[g]); __builtin_amdgcn_sched_barrier(0); }
#pragma unroll
        for (int g = 0; g < 4; g += 2) {
#pragma unroll
            for (int i = 0; i < 16; ++i) Cn[g][i] = fmaxf(Cn[g][i], Cn[g + 1][15 - i]);
            merge16_desc(Cn[g]); }
#pragma unroll
        for (int i = 0; i < 16; ++i) Cn[0][i] = fmaxf(Cn[0][i], Cn[2][15 - i]);
        merge16_desc(Cn[0]);
        float W[16];
#pragma unroll
        for (int k = 0; k < 16; ++k) W[k] = Cn[0][k];
        asm volatile("s_waitcnt lgkmcnt(0)" ::: "memory");
        if (hi == 0) {
            float den = 0.f, e[16];
#pragma unroll
            for (int k = 0; k < 16; ++k) { e[k] = __builtin_amdgcn_exp2f((W[k] - W[0]) * LOG2E); den += e[k]; }
            const float inv = 1.0f / den;
            int* ido = F.IDS + (size_t)(t0 + c32) * PEER_SEL + h * PEER_K; float* gwo = F.GW + (size_t)(t0 + c32) * PEER_SEL + h * PEER_K;
#pragma unroll
            for (int k4 = 0; k4 < 4; ++k4) { int idv[4]; f32x4 gv;
#pragma unroll
                for (int k = 0; k < 4; ++k) { const int code = 255 - (int)(__float_as_uint(W[4 * k4 + k]) & 0xFFu);
                    idv[k] = IDX[(c32 * 2) * 16 + (code >> 4)] * PEER_NK + IDX[(c32 * 2 + 1) * 16 + (code & 15)]; gv[k] = e[4 * k4 + k] * inv; }
                *(GAS v4u*)(ido + 4 * k4) = (v4u){(unsigned)idv[0], (unsigned)idv[1], (unsigned)idv[2], (unsigned)idv[3]}; *(GAS f32x4*)(gwo + 4 * k4) = gv; }
        }
        asm volatile("s_waitcnt lgkmcnt(0)" ::: "memory");
    }
}

__device__ __forceinline__ f32x32v ld_row6(const unsigned char* tab, int id, int lane) {
    const GAS unsigned char* rp = (const GAS unsigned char*)tab + (size_t)id * ROW6 + 24 * lane;
    const v4u_a4 a = *(const GAS v4u_a4*)rp; const v2u_a4 b = *(const GAS v2u_a4*)(rp + 16);
    const u32x6v w = {a[0], a[1], a[2], a[3], b[0], b[1]};
    return __builtin_amdgcn_cvt_scalef32_pk32_f32_fp6(w, 1.0f);
}
constexpr int P9_GE = 4;
__device__ __forceinline__ float readlane_f(float v, int l) { return __int_as_float(__builtin_amdgcn_readlane(__float_as_int(v), l)); }
typedef int i32x8 __attribute__((ext_vector_type(8)));
__device__ __forceinline__ void p9_gather(Frame& F) {
    LAS unsigned char* const RB = F.lds + F.wave * 16384;
    LAS unsigned char* const XL8 = F.lds + P9X_OFF + F.wave * 2048;
    LAS float* const SC = (LAS float*)(F.lds + MISC_OFF + 192 + F.wave * 512);
    int lane_ = F.tid; asm volatile("" : "+v"(lane_));
    const int gw = F.vcu * NWAVES + F.wave, NGW = F.G * NWAVES, lane = lane_ & 63;
    const int e16 = ((lane >> 5) & 1) * 8 + ((lane >> 4) & 1) * 4 + ((lane >> 3) & 1) * 2 + ((lane >> 2) & 1);
    const int srcl16 = ((lane >> 3) & 1) * 32 + ((lane >> 2) & 1) * 16 + ((lane >> 1) & 1) * 8 + (lane & 1) * 4;
    bool inter;
    { f32x16v t0, t1;
#pragma unroll
      for (int j = 0; j < 16; ++j) { t0[j] = 0.125f * j; t1[j] = j < 8 ? 2.0f + 0.25f * j : 4.0f + 0.5f * (j - 8); }
      const f32x32v y = __builtin_amdgcn_cvt_scalef32_pk32_f32_fp6(__builtin_amdgcn_cvt_scalef32_2xpk16_fp6_f32(t0, t1, 1.0f), 1.0f);
      inter = y[1] != 0.125f; }
    bool swap4;
    { const unsigned w = __builtin_amdgcn_cvt_scalef32_pk_fp4_f32(0u, 1.0f, 2.0f, 1.0f, 0); const f32x2 pr = __builtin_amdgcn_cvt_scalef32_pk_f32_fp4(w, 1.0f, 0); swap4 = pr.x != 1.0f; }
    LAS float* const LNG = (LAS float*)F.lds;
    __syncthreads();
    for (int i = F.tid; i < 2 * D / 4; i += NWAVES * 64) { ((LAS f32x4*)LNG)[i] = i < D / 4 ? ((const GAS f32x4*)F.ln2_g)[i] : ((const GAS f32x4*)F.ln2_b)[i - D / 4];
        ((LAS f32x4*)LNG)[2 * D / 4 + i] = i < D / 4 ? ((const GAS f32x4*)F.ln1_g)[i] : ((const GAS f32x4*)F.ln1_b)[i - D / 4]; }
    __syncthreads();
    if (gw >= M) return;
    int idA = F.IDS[(size_t)gw * PEER_SEL + lane], idB = F.IDS[(size_t)gw * PEER_SEL + 64 + lane];
    float gwA = F.GW[(size_t)gw * PEER_SEL + lane], gwB = F.GW[(size_t)gw * PEER_SEL + 64 + lane];
    f32x4 xf[8]; f32x2 st = *(const GAS f32x2*)(F.STAT + 2 * (size_t)gw);
    { const GAS f32x4* xr = (const GAS f32x4*)(F.H1 + (size_t)gw * D + 32 * lane);
#pragma unroll
      for (int k = 0; k < 8; ++k) xf[k] = xr[k]; }
#pragma unroll 1
    for (int t = gw; t < M; t += NGW) {
        int idAn, idBn; float gwAn, gwBn; f32x4 xn[8]; f32x2 stn;
        {
            const LAS f32x4* g1 = (const LAS f32x4*)(LNG + 2 * D + 32 * lane); const LAS f32x4* b1 = (const LAS f32x4*)(LNG + 3 * D + 32 * lane);
#pragma unroll
            for (int k = 0; k < 8; ++k) xf[k] = (xf[k] - st.x) * st.y * g1[k] + b1[k]; }
        float cfA = 0.f, cfB = 0.f;
        {
            const int q4 = lane >> 4, r16 = lane & 15;
            { v4u w0, w1;
#pragma unroll
              for (int k = 0; k < 8; ++k) { const f32x4 a = xf[k]; const unsigned pk = pk4_fp8(a[0], a[1], a[2], a[3]); if (k < 4) w0[k] = pk; else w1[k - 4] = pk; }
              *(LAS v4u*)(XL8 + 32 * lane) = w0; *(LAS v4u*)(XL8 + 32 * lane + 16) = w1; }
            asm volatile("s_waitcnt lgkmcnt(0)" ::: "memory");
            i32x8 xB;
            { const v4u b0 = *(const LAS v4u*)(XL8 + 128 * r16 + 16 * q4), b1 = *(const LAS v4u*)(XL8 + 128 * r16 + 64 + 16 * q4);
              xB = (i32x8){(int)b0.x, (int)b0.y, (int)b0.z, (int)b0.w, (int)b1.x, (int)b1.y, (int)b1.z, (int)b1.w}; }
            const int pofs = 16 * (4 * r16 + q4);
            const bool ondiag = (r16 >> 2) == q4; const int dreg = r16 & 3;
#define P9_LDU(W_, IDV_, b8_) do { _Pragma("unroll") for (int e = 0; e < 8; ++e) \
        W_[e] = *(const GAS v4u*)(F.U8 + (size_t)__builtin_amdgcn_readlane(IDV_, (b8_) * 8 + e) * ROW4 + pofs); } while (0)
#define P9_DOT(W_, P_, o_) do { _Pragma("unroll") for (int e = 0; e < 8; ++e) { const i32x8 aa_ = {(int)W_[e].x, (int)W_[e].y, (int)W_[e].z, (int)W_[e].w, 0, 0, 0, 0}; \
        const f32x4 d_ = __builtin_amdgcn_mfma_scale_f32_16x16x128_f8f6f4(aa_, xB, (f32x4){0.f, 0.f, 0.f, 0.f}, 4  , 0  , 0, 0, 0, 0); \
        const float s_ = dreg == 0 ? d_[0] : (dreg == 1 ? d_[1] : (dreg == 2 ? d_[2] : d_[3])); P_[(o_) + e] = ondiag ? s_ : 0.f; } __builtin_amdgcn_sched_barrier(0); } while (0)
#pragma unroll 1
            for (int hf = 0; hf < 2; ++hf) {
                const int idv = hf ? idB : idA;
                float p[64]; v4u wA[8], wB[8];
                P9_LDU(wA, idv, 0);
#define P9_PAIR(b_) do { P9_LDU(wB, idv, (b_) + 1); __builtin_amdgcn_sched_barrier(0); P9_DOT(wA, p, 8 * (b_)); \
                         if ((b_) + 2 < 8) P9_LDU(wA, idv, (b_) + 2); __builtin_amdgcn_sched_barrier(0); P9_DOT(wB, p, 8 * (b_) + 8); } while (0)
                P9_PAIR(0); P9_PAIR(2); P9_PAIR(4); P9_PAIR(6);
#undef P9_PAIR
#define P9_RS(SRC_, DST_, n_, m_) do { const bool up_ = (lane & (m_)) != 0; _Pragma("unroll") for (int i = 0; i < (n_); ++i) { \
        const float snd = up_ ? SRC_[i] : SRC_[(n_) + i], kp = up_ ? SRC_[(n_) + i] : SRC_[i]; DST_[i] = kp + __shfl_xor(snd, (m_)); } } while (0)
                float q32[32], q16[16], q8[8], q4v[4], q2[2], q1[1];
                P9_RS(p, q32, 32, 32); P9_RS(q32, q16, 16, 16); P9_RS(q16, q8, 8, 8); P9_RS(q8, q4v, 4, 4); P9_RS(q4v, q2, 2, 2); P9_RS(q2, q1, 1, 1);
#undef P9_RS
                const float a = q1[0] * (1.0f / U6_SCALE);
                const float act = 0.5f * a * (1.0f + erff(a * 0.7071067811865476f));
                if (hf) cfB = gwB * act * (1.0f / V6_SCALE); else cfA = gwA * act * (1.0f / V6_SCALE);
            }
#undef P9_LDU
#undef P9_DOT
        }
        float os[32];
#pragma unroll
        for (int i = 0; i < 32; ++i) os[i] = 0.f;
        {
#define P9_LDV(W_, g_) do { const int iv_ = (g_) < 8 ? idA : idB; _Pragma("unroll") for (int e = 0; e < 8; ++e) \
        W_[e] = *((const GAS v4u*)(F.V8 + (size_t)__builtin_amdgcn_readlane(iv_, 8 * ((g_) & 7) + e) * ROW4) + lane); } while (0)
#define P9_ACC(W_, g_) do { const float cv_ = (g_) < 8 ? cfA : cfB; _Pragma("unroll") for (int e = 0; e < 8; ++e) { const float cf = readlane_f(cv_, 8 * ((g_) & 7) + e); const f32x2 cf2 = {cf, cf}; \
        _Pragma("unroll") for (int k = 0; k < 4; ++k) { const unsigned wk = W_[e][k]; \
            const f32x2 p0 = __builtin_amdgcn_cvt_scalef32_pk_f32_fp4(wk, 1.0f, 0), p1 = __builtin_amdgcn_cvt_scalef32_pk_f32_fp4(wk, 1.0f, 1), p2 = __builtin_amdgcn_cvt_scalef32_pk_f32_fp4(wk, 1.0f, 2), p3 = __builtin_amdgcn_cvt_scalef32_pk_f32_fp4(wk, 1.0f, 3); \
            os2[4 * k] = __builtin_elementwise_fma(p0, cf2, os2[4 * k]); os2[4 * k + 1] = __builtin_elementwise_fma(p1, cf2, os2[4 * k + 1]); \
            os2[4 * k + 2] = __builtin_elementwise_fma(p2, cf2, os2[4 * k + 2]); os2[4 * k + 3] = __builtin_elementwise_fma(p3, cf2, os2[4 * k + 3]); } \
        __builtin_amdgcn_sched_barrier(0); } } while (0)
            f32x2 os2[16];
#pragma unroll
            for (int i = 0; i < 16; ++i) os2[i] = (f32x2){0.f, 0.f};
            v4u vA[8], vB[8];
            P9_LDV(vA, 0);
            { const int tn = (t + NGW < M) ? t + NGW : t;
              idAn = F.IDS[(size_t)tn * PEER_SEL + lane]; idBn = F.IDS[(size_t)tn * PEER_SEL + 64 + lane]; gwAn = F.GW[(size_t)tn * PEER_SEL + lane]; gwBn = F.GW[(size_t)tn * PEER_SEL + 64 + lane];
              stn = *(const GAS f32x2*)(F.STAT + 2 * (size_t)tn);
              const GAS f32x4* xr = (const GAS f32x4*)(F.H1 + (size_t)tn * D + 32 * lane);
#pragma unroll
              for (int k = 0; k < 8; ++k) xn[k] = xr[k]; }
            __builtin_amdgcn_sched_barrier(0);
#pragma unroll 1
            for (int g = 0; g < 16; g += 2) {
                P9_LDV(vB, g + 1); __builtin_amdgcn_sched_barrier(0);
                P9_ACC(vA, g);
                if (g + 2 < 16) P9_LDV(vA, g + 2);
                __builtin_amdgcn_sched_barrier(0);
                P9_ACC(vB, g + 1);
            }
#pragma unroll
            for (int i = 0; i < 16; ++i) { os[2 * i] = os2[i].x; os[2 * i + 1] = os2[i].y; }
#undef P9_LDV
#undef P9_ACC
        }
        float on[32];
#pragma unroll
        for (int i = 0; i < 16; ++i) { on[2 * i] = swap4 ? os[2 * i + 1] : os[2 * i]; on[2 * i + 1] = swap4 ? os[2 * i] : os[2 * i + 1]; }
        float s = 0.f;
#pragma unroll
        for (int k = 0; k < 8; ++k) {
#pragma unroll
            for (int i = 0; i < 4; ++i) { on[4 * k + i] += xf[k][i] * DN_ALPHA; s += on[4 * k + i]; } }
        const float mean = wave_sum(s) * (1.f / D); float s2 = 0.f;
#pragma unroll
        for (int i = 0; i < 32; ++i) { on[i] -= mean; s2 += on[i] * on[i]; }
        const float rstd = 1.f / sqrtf(wave_sum(s2) * (1.f / D) + LN_EPS);
        GAS f32x4* orow = (GAS f32x4*)(F.out + (size_t)t * D + 32 * lane);
        const LAS f32x4* gr = (const LAS f32x4*)(LNG + 32 * lane); const LAS f32x4* br = (const LAS f32x4*)(LNG + D + 32 * lane);
#pragma unroll
        for (int k = 0; k < 8; ++k) { const f32x4 g0 = gr[k], b0 = br[k]; f32x4 y0;
#pragma unroll
            for (int i = 0; i < 4; ++i) y0[i] = on[4 * k + i] * rstd * g0[i] + b0[i];
            orow[k] = y0; }
        idA = idAn; idB = idBn; gwA = gwAn; gwB = gwBn; st = stn;
#pragma unroll
        for (int k = 0; k < 8; ++k) xf[k] = xn[k];
    }
}

struct Args { const float* in[16]; float* out; unsigned char* ws; int ph_lo, ph_hi; };
__global__ void __launch_bounds__(NWAVES * 64, 2) mk_fwd(Args args) {
    extern __shared__ __attribute__((aligned(16))) unsigned char lds[];
    Frame F;
    F.lds = (LAS unsigned char*)lds;
    F.MISC = (volatile LAS unsigned*)(F.lds + MISC_OFF);
    F.tid = threadIdx.x; F.lane = F.tid & 63; F.wave = __builtin_amdgcn_readfirstlane(F.tid >> 6);
    F.G = gridDim.x; { const int bx = blockIdx.x; F.vcu = (F.G % 8 == 0) ? (bx % 8) * (F.G / 8) + bx / 8 : bx; }
    unsigned char* ws = args.ws;
    F.ctl = (gu32*)(ws + WS_CTL);
    F.x = args.in[0]; F.w_in = args.in[1]; F.w_gate = args.in[2]; F.b_gate = args.in[3]; F.w_bsb = args.in[4]; F.w_bmb = args.in[5]; F.w_out = args.in[6]; F.rel_bias = args.in[7];
    F.ln1_g = args.in[8]; F.ln1_b = args.in[9]; F.w_pq = args.in[10]; F.subkeys = args.in[11]; F.peer_u = args.in[12]; F.peer_v = args.in[13]; F.ln2_g = args.in[14]; F.ln2_b = args.in[15];
    F.out = args.out;
    F.KMEAN = (float*)(ws + WS_KMEAN); F.WIG = (bf16*)(ws + WS_WIG); F.WSB = (bf16*)(ws + WS_WSB); F.WMB = (bf16*)(ws + WS_WMB); F.WOUT = (bf16*)(ws + WS_WOUT); F.WPQ = (bf16*)(ws + WS_WPQ);
    F.IDS = (int*)(ws + WS_IDS); F.GW = (float*)(ws + WS_GW);
    F.QKV = (bf16*)(ws + WS_QKV); F.MIXED = (bf16*)(ws + WS_MIXED); F.GATE = (bf16*)(ws + WS_GATE); F.XB = (bf16*)(ws + WS_XB); F.OSB = (bf16*)(ws + WS_OSB); F.OMB = (bf16*)(ws + WS_OMB);
    F.X1B = (bf16*)(ws + WS_X1B); F.H1 = (float*)(ws + WS_H1); F.QP = (float*)(ws + WS_QP); F.QPB = (bf16*)(ws + WS_QP); F.U8 = ws + WS_U8; F.V8 = ws + WS_V8; F.STAT = (float*)(ws + WS_STAT);
    for (int u = F.tid; u < (LDS_BYTES - LDSCTL_OFF) / 4; u += NWAVES * 64) ((LAS unsigned*)(F.lds + LDSCTL_OFF))[u] = 0u;
    __syncthreads();
    XcdBarrier bar; bar.bar = (unsigned*)(F.ctl + CW_BAR); bar.x = 0; bar.st = nullptr;
    if (N_LAUNCHES == 1) bar = xcd_barrier_post((unsigned*)(F.ctl + CW_BAR), F.MISC + 8);
    const int lo = args.ph_lo, hi = args.ph_hi;
#ifndef PHASE_MASK
#define PHASE_MASK 0x3ff
#endif
#define IN(k) (((PHASE_MASK >> (k)) & 1) && lo <= (k) && (k) < hi)
#define SEAM(k) do { if (IN(k) && IN((k) + 1)) xcd_barrier(bar); } while (0)
#ifndef PROBE_DUP
#define PROBE_DUP -1
#endif
#define REP(k) for (int rep_ = 0; rep_ < ((PROBE_DUP == (k)) ? 2 : 1); ++rep_)

    if (IN(0)) REP(0) { p0_prologue(F); SEAM(0); }
    if (IN(1)) REP(1) {
        pg8::Gemm g{F.XB, F.WIG, F.XB, F.WIG, M, N1, D / 2}; pg8::StaticOrder S; S.init(M, N1, F.G, (int)blockIdx.x);
        pg8::EpiQkvGate E{F.QKV, F.GATE, F.b_gate, 1.0f / W8_SCALE};
        pg8::gemm_phase<pg8::EpiQkvGate, pg8::StaticOrder, PG8_ALIGN, PG8_SP2, true>(F.lds + RING_OFF, g, S, E);
        SEAM(1);
    }
    if (IN(2)) REP(2) { p2_kmean(F); p2_sb(F); SEAM(2); }
    if (IN(3)) REP(3) { p3_moba(F); SEAM(3); }
    if (IN(4)) REP(4) {
        pg8::Gemm g{F.OSB, F.WSB, F.OMB, F.WMB, M, D, HW}; pg8::DualOrder S; S.init(M, D, F.G, (int)blockIdx.x);
        pg8::EpiBranch E{F.GATE, F.MIXED};
        pg8::gemm_phase<pg8::EpiBranch, pg8::DualOrder, PG8_ALIGN, PG8_SP2>(F.lds + RING_OFF, g, S, E);
        SEAM(4);
    }
    if (IN(5)) REP(5) {
        pg8::Gemm g{F.MIXED, F.WOUT, F.MIXED, F.WOUT, M, D, D / 2}; pg8::StaticOrder S; S.init(M, D, F.G, (int)blockIdx.x);
        pg8::EpiF32 E{F.H1, F.x, DN_ALPHA, D, 1.0f / W8_SCALE};
        pg8::gemm_phase<pg8::EpiF32, pg8::StaticOrder, PG8_ALIGN, PG8_SP2, true>(F.lds + RING_OFF, g, S, E);
        SEAM(5);
    }
    if (IN(6)) REP(6) { p6_ln1(F); SEAM(6); }
    if (IN(7)) REP(7) {
        pg8::Gemm g{F.X1B, F.WPQ, F.X1B, F.WPQ, M, D, D}; pg8::StaticOrder S; S.init(M, D, F.G, (int)blockIdx.x);
        pg8::EpiBf16 E{F.QPB, D};
        pg8::gemm_phase<pg8::EpiBf16, pg8::StaticOrder, PG8_ALIGN, PG8_SP2>(F.lds + RING_OFF, g, S, E);
        SEAM(7);
    }
    if (IN(8)) REP(8) { p8_route(F); SEAM(8); }
    if (IN(9)) REP(9) { p9_gather(F); }
#undef IN
#undef SEAM
}

extern "C" void kernel_launch(void* const* d_in, const int* in_sizes, int n_in, void* d_out, int out_size, void* d_ws, size_t ws_size, hipStream_t stream) {
    static int grid = 0;
    if (grid == 0) {
        if (n_in != 16 || in_sizes[0] != M * D || out_size != M * D || ws_size < WS_END) { fprintf(stderr, "kernel_launch: built for 16 inputs, x/out of %d floats, >= %zu bytes of workspace; got n_in %d, in0 %d, out %d, ws %zu; nothing launched\n", M * D, (size_t)WS_END, n_in, n_in > 0 ? in_sizes[0] : -1, out_size, ws_size); grid = -1; return; }
        int dev = 0, cus = 0, per_cu = 0;
        if (hipGetDevice(&dev) != hipSuccess || hipDeviceGetAttribute(&cus, hipDeviceAttributeMultiprocessorCount, dev) != hipSuccess) { fprintf(stderr, "kernel_launch: hipGetDevice / hipDeviceGetAttribute failed\n"); grid = -1; return; }
        if (hipFuncSetAttribute((const void*)mk_fwd, hipFuncAttributeMaxDynamicSharedMemorySize, LDS_BYTES) != hipSuccess) { fprintf(stderr, "kernel_launch: hipFuncSetAttribute failed\n"); grid = -1; return; }
        if (hipOccupancyMaxActiveBlocksPerMultiprocessor(&per_cu, (const void*)mk_fwd, NWAVES * 64, LDS_BYTES) != hipSuccess || per_cu < 1)
            fprintf(stderr, "kernel_launch: note: occupancy query reports %d workgroups per CU\n", per_cu);
        (void)hipGetLastError();
        grid = cus;
    }
    if (grid < 0) return;
    if (hipMemsetAsync((char*)d_ws + WS_CTL, 0, CTL_ZERO_BYTES, stream) != hipSuccess) { fprintf(stderr, "kernel_launch: hipMemsetAsync failed\n"); return; }
    Args a{};
    for (int i = 0; i < 16; ++i) a.in[i] = (const float*)d_in[i];
    a.out = (float*)d_out; a.ws = (unsigned char*)d_ws;
    for (int li = 0; li < N_LAUNCHES; ++li) {
        a.ph_lo = (N_LAUNCHES == 1) ? 0 : li; a.ph_hi = (N_LAUNCHES == 1) ? N_PHASES : li + 1;
        hipLaunchKernelGGL(mk_fwd, dim3(grid), dim3(NWAVES * 64), LDS_BYTES, stream, a);
        const hipError_t le = hipPeekAtLastError();
        if (le != hipSuccess) { fprintf(stderr, "kernel_launch: launch %d failed: %s\n", li, hipGetErrorName(le)); break; }
    }
#ifdef PROBE_PHASE
    a.ph_lo = PROBE_PHASE; a.ph_hi = PROBE_PHASE + 1;
    hipLaunchKernelGGL(mk_fwd, dim3(grid), dim3(NWAVES * 64), LDS_BYTES, stream, a);
#endif
}
```
